# Optimizing an MI355X kernel written in HIP

```python
import jax, jax.numpy as jnp
from jax import lax
import numpy as np

D_MODEL = 4096
BATCH = 4
SEQ = 4096
DEPTH = 1

MIX_WIDTH = D_MODEL
POOL_WIDTH = MIX_WIDTH // 2
CONV_WIDTH = MIX_WIDTH - POOL_WIDTH
POOL_WINDOWS = (2, 4, 8, 16)
N_POOL_GROUPS = len(POOL_WINDOWS)
POOL_GROUP_DIM = POOL_WIDTH // N_POOL_GROUPS
CONV_HEAD_DIM = 128
CONV_HEADS = CONV_WIDTH // CONV_HEAD_DIM
CONV_WIDTH_K = 3
IN_PROJ_WIDTH = POOL_WIDTH + 3 * CONV_WIDTH
D_FF = 4 * D_MODEL
N_MOD = 6
EPS = 1e-6

kernel_name = "hybrid_pool_shortconv_adaln_block"


def rmsnorm(x, g):
    xf = x.astype(jnp.float32)
    xn = xf * lax.rsqrt(jnp.mean(xf * xf, axis=-1, keepdims=True) + EPS)
    return xn.astype(x.dtype) * g


def group_rmsnorm(x, g, n_groups):
    b, s, w = x.shape
    xg = x.reshape(b, s, n_groups, w // n_groups).astype(jnp.float32)
    xn = xg * lax.rsqrt(jnp.mean(xg * xg, axis=-1, keepdims=True) + EPS)
    return xn.reshape(b, s, w).astype(x.dtype) * g


def modulate(h, shift, scale):
    return h * (1 + scale[:, None, :]) + shift[:, None, :]


def multiscale_pool(v):
    b, s, _ = v.shape
    vg = v.reshape(b, s, N_POOL_GROUPS, POOL_GROUP_DIM)
    cs = jnp.cumsum(vg.astype(jnp.float32), axis=1)
    cs = jnp.pad(cs, ((0, 0), (1, 0), (0, 0), (0, 0)))
    half = jnp.array(POOL_WINDOWS, dtype=jnp.int32) // 2
    t = jnp.arange(s, dtype=jnp.int32)[:, None]
    lo = jnp.clip(t - half[None, :], 0, s)
    hi = jnp.clip(t + half[None, :], 0, s)
    gidx = jnp.arange(N_POOL_GROUPS, dtype=jnp.int32)[None, :]
    win_sum = cs[:, hi, gidx, :] - cs[:, lo, gidx, :]
    count = (hi - lo).astype(jnp.float32)[None, :, :, None]
    out = win_sum / count - vg.astype(jnp.float32)
    return out.astype(v.dtype)


def depthwise_conv3_centred(u, w, bias):
    up = jnp.pad(u, ((0, 0), (1, 1), (0, 0)))
    return w[0] * up[:, :-2] + w[1] * up[:, 1:-1] + w[2] * up[:, 2:] + bias


def setup_inputs(seed: int = 0) -> dict:
    key = jax.random.key(seed)
    ks = jax.random.split(key, 20)
    f32 = jnp.float32
    L, D = DEPTH, D_MODEL

    def nrm(k, shape, fan_in):
        return jax.random.normal(k, shape, f32) * (fan_in ** -0.5)

    def gain(k, shape):
        return 1.0 + 0.1 * jax.random.normal(k, shape, f32)

    return {
        "x": jax.random.normal(ks[0], (BATCH, SEQ, D), f32),
        "c": jax.random.normal(ks[1], (BATCH, D), f32),
        "w_ada": nrm(ks[2], (L, D, N_MOD * D), D) * 0.5,
        "b_ada": 0.02 * jax.random.normal(ks[3], (L, N_MOD * D), f32),
        "norm1_g": gain(ks[4], (L, D)),
        "w_in": nrm(ks[5], (L, D, IN_PROJ_WIDTH), D),
        "pool_mix_w": nrm(ks[6], (L, N_POOL_GROUPS, POOL_GROUP_DIM, POOL_GROUP_DIM), POOL_GROUP_DIM),
        "pool_scale": gain(ks[7], (L, POOL_WIDTH)),
        "conv_w": nrm(ks[8], (L, CONV_WIDTH_K, CONV_WIDTH), CONV_WIDTH_K),
        "conv_b": 0.02 * jax.random.normal(ks[9], (L, CONV_WIDTH), f32),
        "gnorm_pool_g": gain(ks[10], (L, POOL_WIDTH)),
        "gnorm_conv_g": gain(ks[11], (L, CONV_WIDTH)),
        "w_out": nrm(ks[12], (L, MIX_WIDTH, D), MIX_WIDTH),
        "norm2_g": gain(ks[13], (L, D)),
        "w_mlp_in": nrm(ks[14], (L, D, D_FF), D),
        "w_mlp_out": nrm(ks[15], (L, D_FF, D), D_FF),
        "final_g": gain(ks[16], (D,)),
    }


def reference(x, c, w_ada, b_ada, norm1_g, w_in, pool_mix_w, pool_scale, conv_w, conv_b,
              gnorm_pool_g, gnorm_conv_g, w_out, norm2_g, w_mlp_in, w_mlp_out, final_g):
    c_act = jax.nn.silu(c)
    for l in range(DEPTH):
        mod = c_act @ w_ada[l] + b_ada[l]
        shift1, scale1, gate1, shift2, scale2, gate2 = jnp.split(mod, N_MOD, axis=-1)

        h = modulate(rmsnorm(x, norm1_g[l]), shift1, scale1)
        proj = jnp.einsum("bsd,de->bse", h, w_in[l])
        v_pool = proj[..., :POOL_WIDTH]
        b_gate, c_gate, u = jnp.split(proj[..., POOL_WIDTH:], 3, axis=-1)

        pooled = multiscale_pool(v_pool)
        a_out = jnp.einsum("bsgd,gde->bsge", pooled, pool_mix_w[l])
        a_out = a_out.reshape(x.shape[0], x.shape[1], POOL_WIDTH) * pool_scale[l]

        b_out = b_gate * depthwise_conv3_centred(c_gate * u, conv_w[l], conv_b[l])

        mixed = jnp.concatenate(
            [group_rmsnorm(a_out, gnorm_pool_g[l], N_POOL_GROUPS),
             group_rmsnorm(b_out, gnorm_conv_g[l], CONV_HEADS)], axis=-1)
        x = x + gate1[:, None, :] * jnp.einsum("bse,ed->bsd", mixed, w_out[l])

        h = modulate(rmsnorm(x, norm2_g[l]), shift2, scale2)
        hid = jnp.square(jax.nn.relu(jnp.einsum("bsd,df->bsf", h, w_mlp_in[l])))
        x = x + gate2[:, None, :] * jnp.einsum("bsf,fd->bsd", hid, w_mlp_out[l])

    return rmsnorm(x, final_g)
```

```cpp
#include <hip/hip_runtime.h>
#include <cstdio>

#define GAS __attribute__((address_space(1)))
#define LAS __attribute__((address_space(3)))
typedef unsigned short bf16_t;
typedef short bf16x8 __attribute__((ext_vector_type(8)));
typedef float f32x4 __attribute__((ext_vector_type(4)));
typedef float f32x2 __attribute__((ext_vector_type(2)));
typedef unsigned u32x4 __attribute__((ext_vector_type(4)));
typedef unsigned u32x2 __attribute__((ext_vector_type(2)));

constexpr int D = 4096, BATCH = 4, SEQ = 4096, M = BATCH * SEQ, NPROJ = 8192, PW = 2048, CW = 2048, FF = 16384, NMODW = 6 * D;
constexpr int PGD = 512;
constexpr bool I8_P5 = true;
constexpr int NQ7 = 64;
constexpr int NQ2 = 0;
constexpr bool PANEL_P0 = true;
constexpr bool R8_HID = true;
constexpr bool I8_P8 = true;
constexpr int PJ = 6144;
constexpr float EPS = 1e-6f;
constexpr int NWAVES = 8;

constexpr size_t MiB = 1u << 20;
constexpr size_t WS_CTL = 0, CTL_ZERO_BYTES = 128 * 1024;
constexpr size_t WS_HMAX = 64 * 1024;
constexpr size_t WS_MODPART = 1 * MiB;
constexpr size_t WS_MODFULL = 4 * MiB;
constexpr size_t WS_STATSP = 5 * MiB;
constexpr size_t WS_STATS1 = 7 * MiB;
constexpr size_t WS_STATS2 = 11 * MiB;
constexpr size_t WS_CS8 = 768 * MiB;
constexpr size_t WS_MIXT = 15 * MiB;
constexpr size_t WS_WIN = 32 * MiB;
constexpr size_t WS_WOUT = 96 * MiB;
constexpr size_t WS_W1 = 128 * MiB;
constexpr size_t WS_W2 = 256 * MiB;
constexpr size_t WS_HB = 384 * MiB;
constexpr size_t WS_HID = 512 * MiB;
constexpr size_t WS_PROJ = 512 * MiB;
constexpr size_t WS_MIXED = 768 * MiB;
constexpr size_t WS_POOLED = 896 * MiB;
constexpr size_t WS_END = 1024 * MiB;
constexpr size_t WS_W1Q = PANEL_P0 ? 960 * MiB : 32 * MiB;
constexpr size_t WS_WOUTQ = PANEL_P0 ? 704 * MiB : 448 * MiB;
constexpr size_t WS_H2Q = 384 * MiB;
constexpr size_t WS_MIXQ = 896 * MiB;
constexpr size_t WS_WINQ = 768 * MiB;
constexpr size_t WS_HIDQ = 128 * MiB;
constexpr size_t WS_SA8 = 20 * MiB + 6 * 65536, WS_SB2 = 20 * MiB + 7 * 65536, WS_CS2 = 20 * MiB + 8 * 65536;
constexpr size_t WS_SA1 = 20 * MiB + 4 * 65536, WS_SBIN = 20 * MiB + 5 * 65536;
constexpr size_t WS_SBOUT = 20 * MiB, WS_SB1 = 20 * MiB + 65536, WS_SA5 = 20 * MiB + 2 * 65536, WS_SA7 = 20 * MiB + 3 * 65536;

constexpr int RING_BYTES = 131072;
constexpr int MISC_OFF = RING_BYTES;
constexpr int LDS_BYTES = 147456;

namespace pg8 {
constexpr int BM = 256, BK = 64, HALF = 128, HTB = HALF * BK * 2, STAGE_BYTES = 8 * HTB, NXCD = 8, WGM = 8;
__host__ __device__ __forceinline__ int lds_byte(int r, int c) { const int st = (r >> 4) * 2 + (c >> 5), rr = r & 15, cc = c & 31, ob = rr * 64 + cc * 2; return st * 1024 + (ob ^ (((ob >> 9) & 1) << 5)); }
__host__ __device__ __forceinline__ void stage_rc(int b, int& R, int& C) { const int st = b / 1024, sb = b % 1024, swz = sb ^ (((sb >> 9) & 1) << 5); R = (st >> 1) * 16 + swz / 64; C = (st & 1) * 32 + (swz % 64) / 2; }
__host__ __device__ __forceinline__ int perm32(int rho) { const int n = rho >> 4, i = rho & 15; return 8 * (i >> 2) + 4 * n + (i & 3); }

typedef int i32x4 __attribute__((ext_vector_type(4)));
__device__ __forceinline__ f32x4 mma16(bf16x8 b, bf16x8 a, f32x4 c) { return __builtin_amdgcn_mfma_f32_16x16x32_bf16(b, a, c, 0, 0, 0); }
__device__ __forceinline__ i32x4 mma16(bf16x8 b, bf16x8 a, i32x4 c) { return __builtin_amdgcn_mfma_i32_16x16x64_i8(__builtin_bit_cast(i32x4, b), __builtin_bit_cast(i32x4, a), c, 0, 0, 0); }
typedef _Float16 f16x2 __attribute__((ext_vector_type(2)));
__device__ __forceinline__ unsigned cvt_pk_h(float lo, float hi) { const f16x2 v = {(_Float16)lo, (_Float16)hi}; return __builtin_bit_cast(unsigned, v); }
__device__ __forceinline__ float hlo(unsigned w) { return (float)__builtin_bit_cast(f16x2, w)[0]; }
__device__ __forceinline__ float hhi(unsigned w) { return (float)__builtin_bit_cast(f16x2, w)[1]; }
struct Unit { int pm, pn; };
struct Gemm { const bf16_t* A; const bf16_t* Bt; int K, lda, ldb; };

struct StaticOrder {
    int nM, nN, nwg, G, c, acol_shift, acol_mul;
    __device__ void init(int M_, int N_, int G_, int c_, int sh = 0, int mul = 0) { nM = M_ / BM; nN = N_ / BM; nwg = nM * nN; G = G_; c = c_; acol_shift = sh; acol_mul = mul; }
    __device__ bool next(int i, Unit& u) const {
        const long L = (long)i * G + c; if (L >= nwg) return false;
        int wgid = (int)L; { const int q = nwg / NXCD, r = nwg % NXCD, xcd = wgid % NXCD, off = wgid / NXCD; wgid = (xcd < r ? xcd * (q + 1) : r * (q + 1) + (xcd - r) * q) + off; }
        const int nig = WGM * nN, gid = wgid / nig, fm = gid * WGM, gsz = (nM - fm) < WGM ? (nM - fm) : WGM;
        u.pm = fm + ((wgid % nig) % gsz); u.pn = (wgid % nig) / gsz; return true;
    }
    __device__ __forceinline__ int a_coloff(const Unit& u) const { return (u.pn >> acol_shift) * acol_mul; }
};

__device__ __forceinline__ float xrow_max(float v) {
    float a = v, b = v; asm volatile("s_nop 1\n\tv_permlane16_swap_b32 %0, %1" : "+v"(a), "+v"(b)); v = fmaxf(a, b);
    a = v; b = v; asm volatile("s_nop 1\n\tv_permlane32_swap_b32 %0, %1" : "+v"(a), "+v"(b)); return fmaxf(a, b);
}
__device__ __forceinline__ float xrow_sum(float v) {
    float a = v, b = v; asm volatile("s_nop 1\n\tv_permlane16_swap_b32 %0, %1" : "+v"(a), "+v"(b)); v = a + b;
    a = v; b = v; asm volatile("s_nop 1\n\tv_permlane32_swap_b32 %0, %1" : "+v"(a), "+v"(b)); return a + b;
}
__device__ __forceinline__ unsigned pack4_rne(float a, float b, float c, float d, float inv) {
    constexpr float MAGIC = 12582912.0f;
    const unsigned ua = __builtin_bit_cast(unsigned, __builtin_fmaf(a, inv, MAGIC)), ub = __builtin_bit_cast(unsigned, __builtin_fmaf(b, inv, MAGIC));
    const unsigned uc = __builtin_bit_cast(unsigned, __builtin_fmaf(c, inv, MAGIC)), ud = __builtin_bit_cast(unsigned, __builtin_fmaf(d, inv, MAGIC));
    return __builtin_amdgcn_perm(__builtin_amdgcn_perm(ud, uc, 0x0c0c0400u), __builtin_amdgcn_perm(ub, ua, 0x0c0c0400u), 0x05040100u);
}
__device__ __forceinline__ unsigned cvt_pk_bf16(float lo, float hi) { unsigned r; asm volatile("v_cvt_pk_bf16_f32 %0, %1, %2" : "=v"(r) : "v"(lo), "v"(hi)); return r; }

template <int ACT  > struct EpiBf16 {
    static constexpr bool PERM = true; typedef f32x4 acc_t;
    bf16_t* O; int ldc; unsigned* hmax;
    __device__ __forceinline__ void operator()(const f32x4 (&acc)[2][2][4][2], const Unit& u, int wr, int wc, int fr, int fq) const {
        const int row0 = u.pm * BM + wr * 64 + fr, col0 = u.pn * BM + wc * 32 + 8 * fq;
#pragma unroll
        for (int ai = 0; ai < 2; ++ai)
#pragma unroll
            for (int m = 0; m < 4; ++m) { const int row = row0 + ai * HALF + m * 16; bf16_t* rowp = O + (size_t)row * ldc + col0; float mxv = 0.f;
#pragma unroll
                for (int bj = 0; bj < 2; ++bj) { f32x4 v0 = acc[ai][bj][m][0], v1 = acc[ai][bj][m][1];
                    if (ACT == 1) {
#pragma unroll
                        for (int j = 0; j < 4; ++j) { const float a = fmaxf(v0[j], 0.f), b = fmaxf(v1[j], 0.f); v0[j] = a * a; v1[j] = b * b; mxv = fmaxf(mxv, fmaxf(v0[j], v1[j])); } }
                    u32x4 w; w.x = cvt_pk_bf16(v0[0], v0[1]); w.y = cvt_pk_bf16(v0[2], v0[3]); w.z = cvt_pk_bf16(v1[0], v1[1]); w.w = cvt_pk_bf16(v1[2], v1[3]);
                    *(u32x4*)(rowp + bj * HALF) = w; }
                if (ACT == 1 && hmax) { mxv = fmaxf(mxv, __shfl_xor(mxv, 16)); mxv = fmaxf(mxv, __shfl_xor(mxv, 32));
                    if (fq == 0) __hip_atomic_fetch_max(hmax + row, __builtin_bit_cast(unsigned, mxv), __ATOMIC_RELAXED, __HIP_MEMORY_SCOPE_AGENT); } }
    }
};
struct EpiProj {
    static constexpr bool PERM = true; typedef f32x4 acc_t;
    bf16_t* O; int pn0;
    __device__ __forceinline__ void operator()(const f32x4 (&acc)[2][2][4][2], const Unit& u_, int wr, int wc, int fr, int fq) const {
        Unit u = u_; u.pn += pn0;
        const int row0 = u.pm * BM + wr * 64 + fr;
        if (u.pn < 16) {
            const int col0 = u.pn * BM + wc * 32 + 8 * fq;
#pragma unroll
            for (int ai = 0; ai < 2; ++ai)
#pragma unroll
                for (int m = 0; m < 4; ++m) { bf16_t* rowp = O + (size_t)(row0 + ai * HALF + m * 16) * PJ + col0;
#pragma unroll
                    for (int bj = 0; bj < 2; ++bj) { const f32x4 v0 = acc[ai][bj][m][0], v1 = acc[ai][bj][m][1];
                        u32x4 w; w.x = cvt_pk_bf16(v0[0], v0[1]); w.y = cvt_pk_bf16(v0[2], v0[3]); w.z = cvt_pk_bf16(v1[0], v1[1]); w.w = cvt_pk_bf16(v1[2], v1[3]);
                        *(GAS u32x4*)(rowp + bj * HALF) = w; } }
        } else {
            const int col0 = 2 * PW + (u.pn - 16) * HALF + wc * 32 + 8 * fq;
#pragma unroll
            for (int ai = 0; ai < 2; ++ai)
#pragma unroll
                for (int m = 0; m < 4; ++m) { const f32x4 v0 = acc[ai][0][m][0] * acc[ai][1][m][0], v1 = acc[ai][0][m][1] * acc[ai][1][m][1];
                    u32x4 w; w.x = cvt_pk_bf16(v0[0], v0[1]); w.y = cvt_pk_bf16(v0[2], v0[3]); w.z = cvt_pk_bf16(v1[0], v1[1]); w.w = cvt_pk_bf16(v1[2], v1[3]);
                    *(GAS u32x4*)(O + (size_t)(row0 + ai * HALF + m * 16) * PJ + col0) = w; }
        }
    }
};
struct EpiProjI8 {
    static constexpr bool PERM = true; typedef i32x4 acc_t;
    bf16_t* O; const float* sa; const float* sb;
    __device__ __forceinline__ void operator()(const i32x4 (&acc)[2][2][4][2], const Unit& u, int wr, int wc, int fr, int fq) const {
        const int row0 = u.pm * BM + wr * 64 + fr, col0 = u.pn * BM + wc * 32 + 8 * fq;
        f32x4 sbv[2][2];
#pragma unroll
        for (int bj = 0; bj < 2; ++bj)
#pragma unroll
            for (int n = 0; n < 2; ++n) sbv[bj][n] = *(const GAS f32x4*)(sb + col0 + bj * HALF + 4 * n);
#pragma unroll
        for (int ai = 0; ai < 2; ++ai)
#pragma unroll
            for (int m = 0; m < 4; ++m) { const int row = row0 + ai * HALF + m * 16; const float sar = *(const GAS float*)(sa + row); bf16_t* rowp = O + (size_t)row * PJ + col0;
#pragma unroll
                for (int bj = 0; bj < 2; ++bj) { f32x4 v0, v1;
#pragma unroll
                    for (int j = 0; j < 4; ++j) { v0[j] = (float)acc[ai][bj][m][0][j] * sar * sbv[bj][0][j]; v1[j] = (float)acc[ai][bj][m][1][j] * sar * sbv[bj][1][j]; }
                    u32x4 w; w.x = cvt_pk_bf16(v0[0], v0[1]); w.y = cvt_pk_bf16(v0[2], v0[3]); w.z = cvt_pk_bf16(v1[0], v1[1]); w.w = cvt_pk_bf16(v1[2], v1[3]);
                    *(GAS u32x4*)(rowp + bj * HALF) = w; } }
    }
};
struct EpiPoolMix {
    static constexpr bool PERM = true; typedef f32x4 acc_t;
    bf16_t* O; int ldc; const float* scale; float* stats;
    __device__ __forceinline__ void operator()(const f32x4 (&acc)[2][2][4][2], const Unit& u, int wr, int wc, int fr, int fq) const {
        const int row0 = u.pm * BM + wr * 64 + fr, col0 = u.pn * BM + wc * 32 + 8 * fq;
        f32x4 sv[2][2];
#pragma unroll
        for (int bj = 0; bj < 2; ++bj)
#pragma unroll
            for (int n = 0; n < 2; ++n) sv[bj][n] = *(const GAS f32x4*)(scale + col0 + bj * HALF + 4 * n);
#pragma unroll
        for (int ai = 0; ai < 2; ++ai)
#pragma unroll
            for (int m = 0; m < 4; ++m) { const int row = row0 + ai * HALF + m * 16; bf16_t* rowp = O + (size_t)row * ldc + col0; float ss = 0.f;
#pragma unroll
                for (int bj = 0; bj < 2; ++bj) { const f32x4 v0 = acc[ai][bj][m][0] * sv[bj][0], v1 = acc[ai][bj][m][1] * sv[bj][1];
                    ss += (v0[0] * v0[0] + v0[1] * v0[1]) + (v0[2] * v0[2] + v0[3] * v0[3]) + (v1[0] * v1[0] + v1[1] * v1[1]) + (v1[2] * v1[2] + v1[3] * v1[3]);
                    u32x4 w; w.x = cvt_pk_bf16(v0[0], v0[1]); w.y = cvt_pk_bf16(v0[2], v0[3]); w.z = cvt_pk_bf16(v1[0], v1[1]); w.w = cvt_pk_bf16(v1[2], v1[3]);
                    *(u32x4*)(rowp + bj * HALF) = w; }
                ss = xrow_sum(ss);
                if (fq == 0) stats[(size_t)row * 32 + u.pn * 4 + wc] = ss; }
    }
};
template <bool BASE_BF16> struct EpiResid {
    static constexpr bool PERM = true; typedef f32x4 acc_t;
    const void* base; bf16_t* out; const float* gate  ; float* stats;
    __device__ __forceinline__ void operator()(const f32x4 (&acc)[2][2][4][2], const Unit& u, int wr, int wc, int fr, int fq) const {
        const int row0 = u.pm * BM + wr * 64 + fr, col0 = u.pn * BM + wc * 32 + 8 * fq;
        const float* gp = gate + (size_t)(u.pm >> 4) * NMODW + col0;
        f32x4 gv[2][2];
#pragma unroll
        for (int bj = 0; bj < 2; ++bj)
#pragma unroll
            for (int n = 0; n < 2; ++n) gv[bj][n] = *(const GAS f32x4*)(gp + bj * HALF + 4 * n);
#pragma unroll
        for (int ai = 0; ai < 2; ++ai)
#pragma unroll
            for (int m = 0; m < 4; ++m) { const int row = row0 + ai * HALF + m * 16; const size_t off = (size_t)row * D + col0; float ss = 0.f;
#pragma unroll
                for (int bj = 0; bj < 2; ++bj) { f32x4 b0, b1;
                    if (BASE_BF16) { const u32x4 w = *(const GAS u32x4*)((const bf16_t*)base + off + bj * HALF);
                        b0 = (f32x4){hlo(w.x), hhi(w.x), hlo(w.y), hhi(w.y)};
                        b1 = (f32x4){hlo(w.z), hhi(w.z), hlo(w.w), hhi(w.w)}; }
                    else { b0 = *(const GAS f32x4*)((const float*)base + off + bj * HALF); b1 = *(const GAS f32x4*)((const float*)base + off + bj * HALF + 4); }
                    const f32x4 o0 = b0 + gv[bj][0] * acc[ai][bj][m][0], o1 = b1 + gv[bj][1] * acc[ai][bj][m][1];
                    ss += (o0[0] * o0[0] + o0[1] * o0[1]) + (o0[2] * o0[2] + o0[3] * o0[3]) + (o1[0] * o1[0] + o1[1] * o1[1]) + (o1[2] * o1[2] + o1[3] * o1[3]);
                    u32x4 w; w.x = cvt_pk_h(o0[0], o0[1]); w.y = cvt_pk_h(o0[2], o0[3]); w.z = cvt_pk_h(o1[0], o1[1]); w.w = cvt_pk_h(o1[2], o1[3]);
                    *(GAS u32x4*)(out + off + bj * HALF) = w; }
                ss = xrow_sum(ss);
                if (fq == 0) stats[(size_t)row * 64 + u.pn * 4 + wc] = ss;
                asm volatile("" ::: "memory"); }
    }
};

struct EpiActI8 {
    static constexpr bool PERM = true; typedef i32x4 acc_t;
    bf16_t* O; int ldc; const float* sa; const float* sb; unsigned* hmax;
    __device__ __forceinline__ void operator()(const i32x4 (&acc)[2][2][4][2], const Unit& u, int wr, int wc, int fr, int fq) const {
        const int row0 = u.pm * BM + wr * 64 + fr, col0 = u.pn * BM + wc * 32 + 8 * fq;
        f32x4 sbv[2][2];
#pragma unroll
        for (int bj = 0; bj < 2; ++bj)
#pragma unroll
            for (int n = 0; n < 2; ++n) sbv[bj][n] = *(const GAS f32x4*)(sb + col0 + bj * HALF + 4 * n);
#pragma unroll
        for (int ai = 0; ai < 2; ++ai)
#pragma unroll
            for (int m = 0; m < 4; ++m) { const int row = row0 + ai * HALF + m * 16; const float sar = *(const GAS float*)(sa + row); bf16_t* rowp = O + (size_t)row * ldc + col0; float mxv = 0.f;
#pragma unroll
                for (int bj = 0; bj < 2; ++bj) { f32x4 v0, v1;
#pragma unroll
                    for (int j = 0; j < 4; ++j) { const float a = fmaxf((float)acc[ai][bj][m][0][j] * sar * sbv[bj][0][j], 0.f), b = fmaxf((float)acc[ai][bj][m][1][j] * sar * sbv[bj][1][j], 0.f); v0[j] = a * a; v1[j] = b * b; mxv = fmaxf(mxv, fmaxf(v0[j], v1[j])); }
                    u32x4 w; w.x = cvt_pk_bf16(v0[0], v0[1]); w.y = cvt_pk_bf16(v0[2], v0[3]); w.z = cvt_pk_bf16(v1[0], v1[1]); w.w = cvt_pk_bf16(v1[2], v1[3]);
                    *(GAS u32x4*)(rowp + bj * HALF) = w; }
                if (hmax) { mxv = fmaxf(mxv, __shfl_xor(mxv, 16)); mxv = fmaxf(mxv, __shfl_xor(mxv, 32));
                    if (fq == 0) __hip_atomic_fetch_max(hmax + row, __builtin_bit_cast(unsigned, mxv), __ATOMIC_RELAXED, __HIP_MEMORY_SCOPE_AGENT); } }
    }
};
struct EpiActR8 {
    static constexpr int PERM = 2; typedef i32x4 acc_t;
    unsigned char* O; int ldc; const float* sa; const float* sb; float* cs;
    __device__ __forceinline__ void operator()(const i32x4 (&acc)[2][2][4][2], const Unit& u, int wr, int wc, int fr, int fq) const {
        const int row0 = u.pm * BM + wr * 64 + fr, col0 = u.pn * BM + wc * 64 + 16 * fq;
        f32x4 sbv[2][2];
#pragma unroll
        for (int bj = 0; bj < 2; ++bj)
#pragma unroll
            for (int n = 0; n < 2; ++n) sbv[bj][n] = *(const GAS f32x4*)(sb + col0 + 8 * bj + 4 * n);
#pragma unroll
        for (int ai = 0; ai < 2; ++ai)
#pragma unroll
            for (int m = 0; m < 4; ++m) { const int row = row0 + ai * HALF + m * 16; float r[16]; float mx = 0.f;
#pragma unroll
                for (int bj = 0; bj < 2; ++bj)
#pragma unroll
                    for (int n = 0; n < 2; ++n)
#pragma unroll
                        for (int j = 0; j < 4; ++j) { const float v = fmaxf((float)acc[ai][bj][m][n][j], 0.f) * sbv[bj][n][j]; r[8 * bj + 4 * n + j] = v; mx = fmaxf(mx, v); }
                mx = xrow_max(mx);
                const float inv = mx > 0.f ? 255.0f * __builtin_amdgcn_rcpf(mx) : 0.f; unsigned o[4];
#pragma unroll
                for (int d = 0; d < 4; ++d) o[d] = pack4_rne(r[4 * d], r[4 * d + 1], r[4 * d + 2], r[4 * d + 3], inv);
                *(GAS u32x4*)(O + (size_t)row * ldc + col0) = (u32x4){o[0], o[1], o[2], o[3]};
                cs[(size_t)row * (ldc >> 6) + u.pn * 4 + wc] = mx * *(const GAS float*)(sa + row) * (1.0f / 255.0f);
                asm volatile("" ::: "memory"); }
    }
};
struct EpiResidI8 {
    static constexpr bool PERM = true; typedef i32x4 acc_t;
    const float* base; bf16_t* out; const float* gate; float* stats; const float* sa; const float* sb;
    __device__ __forceinline__ void operator()(const i32x4 (&acc)[2][2][4][2], const Unit& u, int wr, int wc, int fr, int fq) const {
        const int row0 = u.pm * BM + wr * 64 + fr, col0 = u.pn * BM + wc * 32 + 8 * fq;
        const float* gp = gate + (size_t)(u.pm >> 4) * NMODW + col0;
        f32x4 gv[2][2];
#pragma unroll
        for (int bj = 0; bj < 2; ++bj)
#pragma unroll
            for (int n = 0; n < 2; ++n) gv[bj][n] = *(const GAS f32x4*)(gp + bj * HALF + 4 * n) * *(const GAS f32x4*)(sb + col0 + bj * HALF + 4 * n);
#pragma unroll
        for (int ai = 0; ai < 2; ++ai)
#pragma unroll
            for (int m = 0; m < 4; ++m) { const int row = row0 + ai * HALF + m * 16; const size_t off = (size_t)row * D + col0; float ss = 0.f; const float sar = *(const GAS float*)(sa + row);
#pragma unroll
                for (int bj = 0; bj < 2; ++bj) { const f32x4 b0 = *(const GAS f32x4*)(base + off + bj * HALF), b1 = *(const GAS f32x4*)(base + off + bj * HALF + 4); f32x4 o0, o1;
#pragma unroll
                    for (int j = 0; j < 4; ++j) { o0[j] = b0[j] + gv[bj][0][j] * ((float)acc[ai][bj][m][0][j] * sar); o1[j] = b1[j] + gv[bj][1][j] * ((float)acc[ai][bj][m][1][j] * sar); }
                    ss += (o0[0] * o0[0] + o0[1] * o0[1]) + (o0[2] * o0[2] + o0[3] * o0[3]) + (o1[0] * o1[0] + o1[1] * o1[1]) + (o1[2] * o1[2] + o1[3] * o1[3]);
                    u32x4 w; w.x = cvt_pk_h(o0[0], o0[1]); w.y = cvt_pk_h(o0[2], o0[3]); w.z = cvt_pk_h(o1[0], o1[1]); w.w = cvt_pk_h(o1[2], o1[3]);
                    *(GAS u32x4*)(out + off + bj * HALF) = w; }
                ss = xrow_sum(ss);
                if (fq == 0) stats[(size_t)row * 64 + u.pn * 4 + wc] = ss;
                asm volatile("" ::: "memory"); }
    }
};

struct EpiResidQ8 {
    static constexpr bool PERM = true, H16 = false; typedef i32x4 acc_t;
    const bf16_t* base; bf16_t* out; const float* gate; float* stats; const float* sa; const float* sb; const int* csum;
    __device__ __forceinline__ void operator()(const i32x4 (&acc)[2][2][4][2], const Unit& u, int wr, int wc, int fr, int fq) const {
        const int row0 = u.pm * BM + wr * 64 + fr, col0 = u.pn * BM + wc * 32 + 8 * fq;
        const float* gp = gate + (size_t)(u.pm >> 4) * NMODW + col0;
        f32x4 gv[2][2]; i32x4 cs[2][2];
#pragma unroll
        for (int bj = 0; bj < 2; ++bj)
#pragma unroll
            for (int n = 0; n < 2; ++n) { gv[bj][n] = *(const GAS f32x4*)(gp + bj * HALF + 4 * n) * *(const GAS f32x4*)(sb + col0 + bj * HALF + 4 * n);
                cs[bj][n] = *(const GAS i32x4*)(csum + col0 + bj * HALF + 4 * n) * 128; }
#pragma unroll
        for (int ai = 0; ai < 2; ++ai)
#pragma unroll
            for (int m = 0; m < 4; ++m) { const int row = row0 + ai * HALF + m * 16; const size_t off = (size_t)row * D + col0; float ss = 0.f; const float sar = *(const GAS float*)(sa + row);
#pragma unroll
                for (int bj = 0; bj < 2; ++bj) { const u32x4 w = *(const GAS u32x4*)(base + off + bj * HALF);
                    const f32x4 b0 = (f32x4){hlo(w.x), hhi(w.x), hlo(w.y), hhi(w.y)}, b1 = (f32x4){hlo(w.z), hhi(w.z), hlo(w.w), hhi(w.w)};
                    const i32x4 a0 = acc[ai][bj][m][0] + cs[bj][0], a1 = acc[ai][bj][m][1] + cs[bj][1]; f32x4 o0, o1;
#pragma unroll
                    for (int j = 0; j < 4; ++j) { o0[j] = b0[j] + gv[bj][0][j] * ((float)a0[j] * sar); o1[j] = b1[j] + gv[bj][1][j] * ((float)a1[j] * sar); }
                    ss += (o0[0] * o0[0] + o0[1] * o0[1]) + (o0[2] * o0[2] + o0[3] * o0[3]) + (o1[0] * o1[0] + o1[1] * o1[1]) + (o1[2] * o1[2] + o1[3] * o1[3]);
                    u32x4 wq; wq.x = cvt_pk_h(o0[0], o0[1]); wq.y = cvt_pk_h(o0[2], o0[3]); wq.z = cvt_pk_h(o1[0], o1[1]); wq.w = cvt_pk_h(o1[2], o1[3]);
                    *(GAS u32x4*)(out + off + bj * HALF) = wq; }
                ss = xrow_sum(ss);
                if (fq == 0) stats[(size_t)row * 64 + u.pn * 4 + wc] = ss;
                asm volatile("" ::: "memory"); }
    }
};

template <class Epi, class Sched, bool ALIGN_EPI = true, bool SP2 = true>
__device__ __forceinline__ void gemm_phase(LAS unsigned char* lds, const Gemm g, const Sched& S, const Epi& E) {
    int tid_ = threadIdx.x; asm volatile("" : "+v"(tid_));
    const int tid = tid_, wid = __builtin_amdgcn_readfirstlane(tid >> 6), lane = tid & 63, wr = wid >> 2, wc = wid & 3, fr = lane & 15, fq = lane >> 4;
    const int K = g.K, nt = K / BK;
    unsigned voffA[2], voffB[2];
#pragma unroll
    for (int i = 0; i < 2; ++i) { int R, C; stage_rc(tid * 16 + i * 8192, R, C); const int Rb = (Epi::PERM == 2) ? (64 * (R >> 5) + 16 * ((R >> 2) & 3) + 4 * ((R >> 4) & 1) + (R & 3)) : Epi::PERM ? ((R & ~31) + perm32(R & 31)) : R;
        voffA[i] = (unsigned)(R * g.lda + C) * 2u; voffB[i] = (unsigned)(Rb * g.ldb + C) * 2u; }
    const size_t kstep = (size_t)(BK * 2);
    const size_t hstepA = (size_t)HALF * g.lda * 2, hstepB = (size_t)((Epi::PERM == 2) ? 8 : HALF) * g.ldb * 2;
    const size_t tstepA = 2 * hstepA, tstepB = (size_t)BM * g.ldb * 2;
    const unsigned ldsw = (unsigned)wid * 1024u;
    const int aoff = lds_byte(wr * 64 + fr, fq * 8), boff = lds_byte(wc * 32 + fr, fq * 8);
#define PG8_SA(b, h) (((b) * 2 + (h)) * HTB)
#define PG8_SB(b, h) ((4 + (b) * 2 + (h)) * HTB)
#define PG8_STAGE(bufoff, gbase, voff) do { _Pragma("unroll") for (int _i = 0; _i < 2; ++_i) \
        __builtin_amdgcn_global_load_lds((const unsigned*)((const char*)(gbase) + (voff)[_i]), (LAS unsigned*)(lds + (bufoff) + ldsw + _i * 8192), 16, 0, 0); } while (0)
#define PG8_LDA(dst, b, h) do { _Pragma("unroll") for (int m = 0; m < 4; ++m) _Pragma("unroll") for (int k = 0; k < 2; ++k) dst[m][k] = *(const LAS bf16x8*)(lds + PG8_SA(b, h) + aoff + m * 2048 + k * 1024); } while (0)
#define PG8_LDB(dst, b, h) do { _Pragma("unroll") for (int n = 0; n < 2; ++n) _Pragma("unroll") for (int k = 0; k < 2; ++k) dst[n][k] = *(const LAS bf16x8*)(lds + PG8_SB(b, h) + boff + n * 2048 + k * 1024); } while (0)
#define PG8_MMA(ai, bj, At, Bt) do { __builtin_amdgcn_s_setprio(1); _Pragma("unroll") for (int m = 0; m < 4; ++m) _Pragma("unroll") for (int n = 0; n < 2; ++n) _Pragma("unroll") for (int k = 0; k < 2; ++k) \
        acc[ai][bj][m][n] = mma16(Bt[n][k], At[m][k], acc[ai][bj][m][n]); __builtin_amdgcn_s_setprio(0); } while (0)
#define PG8_WAIT_V(n) asm volatile("s_waitcnt vmcnt(" #n ")" ::: "memory")
#define PG8_WAIT_L(n) asm volatile("s_waitcnt lgkmcnt(" #n ")" ::: "memory")
#define PG8_BAR __builtin_amdgcn_s_barrier()
#define PG8_SCHED __builtin_amdgcn_sched_barrier(0)
    Unit cur, nxt; int ui = 0;
    if (!S.next(0, cur)) return;
    typedef typename Epi::acc_t acc_t;
    acc_t acc[2][2][4][2];
#pragma unroll
    for (int a = 0; a < 2; ++a)
#pragma unroll
        for (int b = 0; b < 2; ++b)
#pragma unroll
            for (int m = 0; m < 4; ++m)
#pragma unroll
                for (int n = 0; n < 2; ++n) acc[a][b][m][n] = (acc_t){0, 0, 0, 0};
    bf16x8 At[4][2], B0[2][2], B1[2][2];
    const char* cA = (const char*)g.A + (size_t)cur.pm * tstepA + (size_t)S.a_coloff(cur) * 2; const char* cB = (const char*)g.Bt + (size_t)cur.pn * tstepB;
    if constexpr (SP2) {
        PG8_STAGE(PG8_SB(0, 0), cB, voffB); PG8_STAGE(PG8_SB(0, 1), cB + hstepB, voffB); PG8_STAGE(PG8_SA(0, 0), cA, voffA); PG8_STAGE(PG8_SA(0, 1), cA + hstepA, voffA);
        if (wr == 1) PG8_BAR;
        PG8_WAIT_V(2); PG8_BAR;
        PG8_STAGE(PG8_SB(1, 0), cB + kstep, voffB); PG8_STAGE(PG8_SA(1, 0), cA + kstep, voffA); PG8_STAGE(PG8_SB(1, 1), cB + hstepB + kstep, voffB);
        PG8_WAIT_V(6); PG8_BAR;
    } else {
        PG8_STAGE(PG8_SB(0, 0), cB, voffB); PG8_STAGE(PG8_SA(0, 0), cA, voffA); PG8_STAGE(PG8_SB(0, 1), cB + hstepB, voffB); PG8_STAGE(PG8_SA(0, 1), cA + hstepA, voffA);
        if (wr == 1) PG8_BAR;
        PG8_WAIT_V(4); PG8_BAR;
        PG8_STAGE(PG8_SB(1, 0), cB + kstep, voffB); PG8_STAGE(PG8_SA(1, 0), cA + kstep, voffA); PG8_STAGE(PG8_SB(1, 1), cB + hstepB + kstep, voffB);
        PG8_WAIT_V(6); PG8_BAR;
    }
    for (;;) {
        const bool has_next = S.next(ui + 1, nxt);
        const char* nA = has_next ? (const char*)g.A + (size_t)nxt.pm * tstepA + (size_t)S.a_coloff(nxt) * 2 : cA; const char* nB = has_next ? (const char*)g.Bt + (size_t)nxt.pn * tstepB : cB;
        for (int t = 0; t < nt; t += 2) {
            const bool last = (t == nt - 2);
            const char* a1 = cA + (size_t)(t + 1) * kstep;
            const char* a2 = last ? nA : cA + (size_t)(t + 2) * kstep; const char* b2 = last ? nB : cB + (size_t)(t + 2) * kstep;
            const char* a3 = a2 + kstep; const char* b3 = b2 + kstep;
            if constexpr (SP2) {
            PG8_LDB(B0, 0, 0); PG8_LDB(B1, 0, 1); PG8_SCHED; PG8_LDA(At, 0, 0); PG8_STAGE(PG8_SA(1, 1), a1 + hstepA, voffA);
            PG8_WAIT_V(8); PG8_WAIT_L(0); PG8_BAR; PG8_MMA(0, 0, At, B0); PG8_MMA(0, 1, At, B1); PG8_BAR; PG8_SCHED;
            PG8_LDA(At, 0, 1); PG8_STAGE(PG8_SB(0, 0), b2, voffB); PG8_STAGE(PG8_SB(0, 1), b2 + hstepB, voffB); PG8_STAGE(PG8_SA(0, 0), a2, voffA);
            PG8_WAIT_V(8); PG8_WAIT_L(0); PG8_BAR; PG8_MMA(1, 0, At, B0); PG8_MMA(1, 1, At, B1); PG8_BAR; PG8_SCHED;
            PG8_LDB(B0, 1, 0); PG8_LDB(B1, 1, 1); PG8_SCHED; PG8_LDA(At, 1, 0); PG8_STAGE(PG8_SA(0, 1), a2 + hstepA, voffA);
            PG8_WAIT_V(8); PG8_WAIT_L(0); PG8_BAR; PG8_MMA(0, 0, At, B0); PG8_MMA(0, 1, At, B1); PG8_BAR; PG8_SCHED;
            PG8_LDA(At, 1, 1); PG8_STAGE(PG8_SB(1, 0), b3, voffB); PG8_STAGE(PG8_SB(1, 1), b3 + hstepB, voffB); PG8_STAGE(PG8_SA(1, 0), a3, voffA);
            PG8_WAIT_V(8); PG8_WAIT_L(0); PG8_BAR; PG8_MMA(1, 0, At, B0); PG8_MMA(1, 1, At, B1); PG8_BAR; PG8_SCHED;
            } else {
            PG8_LDB(B0, 0, 0); PG8_SCHED; PG8_LDA(At, 0, 0); PG8_STAGE(PG8_SA(1, 1), a1 + hstepA, voffA);
            PG8_WAIT_L(8); PG8_BAR; PG8_WAIT_L(0); PG8_MMA(0, 0, At, B0); PG8_BAR; PG8_SCHED;
            PG8_LDB(B1, 0, 1); PG8_STAGE(PG8_SB(0, 0), b2, voffB);
            PG8_BAR; PG8_WAIT_L(0); PG8_MMA(0, 1, At, B1); PG8_BAR;
            PG8_LDA(At, 0, 1); PG8_STAGE(PG8_SA(0, 0), a2, voffA);
            PG8_BAR; PG8_WAIT_L(0); PG8_MMA(1, 0, At, B0); PG8_BAR; PG8_SCHED;
            PG8_STAGE(PG8_SB(0, 1), b2 + hstepB, voffB);
            PG8_WAIT_V(6); PG8_BAR; PG8_MMA(1, 1, At, B1); PG8_BAR;
            PG8_LDB(B0, 1, 0); PG8_SCHED; PG8_LDA(At, 1, 0); PG8_STAGE(PG8_SA(0, 1), a2 + hstepA, voffA);
            PG8_WAIT_L(8); PG8_BAR; PG8_WAIT_L(0); PG8_MMA(0, 0, At, B0); PG8_BAR; PG8_SCHED;
            PG8_LDB(B1, 1, 1); PG8_STAGE(PG8_SB(1, 0), b3, voffB);
            PG8_BAR; PG8_WAIT_L(0); PG8_MMA(0, 1, At, B1); PG8_BAR;
            PG8_LDA(At, 1, 1); PG8_STAGE(PG8_SA(1, 0), a3, voffA);
            PG8_BAR; PG8_WAIT_L(0); PG8_MMA(1, 0, At, B0); PG8_BAR; PG8_SCHED;
            PG8_STAGE(PG8_SB(1, 1), b3 + hstepB, voffB);
            PG8_WAIT_V(6); PG8_BAR; PG8_MMA(1, 1, At, B1); PG8_BAR;
            }
        }
        if constexpr (ALIGN_EPI) { if (wr == 0) PG8_BAR; }
        E(acc, cur, wr, wc, fr, fq);
        if (!has_next) break;
#pragma unroll
        for (int a = 0; a < 2; ++a)
#pragma unroll
            for (int b = 0; b < 2; ++b)
#pragma unroll
                for (int m = 0; m < 4; ++m)
#pragma unroll
                    for (int n = 0; n < 2; ++n) acc[a][b][m][n] = (acc_t){0, 0, 0, 0};
        cur = nxt; cA = nA; cB = nB; ++ui;
        if constexpr (ALIGN_EPI) { if (wr == 1) PG8_BAR; }
    }
    PG8_WAIT_V(0);
    if constexpr (!ALIGN_EPI) { if (wr == 0) PG8_BAR; }
    PG8_BAR;
#undef PG8_SA
#undef PG8_SB
#undef PG8_STAGE
#undef PG8_LDA
#undef PG8_LDB
#undef PG8_MMA
#undef PG8_WAIT_V
#undef PG8_WAIT_L
#undef PG8_BAR
#undef PG8_SCHED
}
}

#define LDS_WAIT() asm volatile("s_waitcnt lgkmcnt(0)" ::: "memory")
__device__ __forceinline__ unsigned f2bf(float f) { unsigned u = __builtin_bit_cast(unsigned, f); return (u + 0x7fffu + ((u >> 16) & 1u)) >> 16; }
__device__ __forceinline__ unsigned pk2(float lo, float hi) { return pg8::cvt_pk_bf16(lo, hi); }
__device__ __forceinline__ float bflo(unsigned w) { return __builtin_bit_cast(float, w << 16); }
__device__ __forceinline__ float bfhi(unsigned w) { return __builtin_bit_cast(float, w & 0xffff0000u); }
__device__ __forceinline__ void unpack8(const u32x4 w, float (&v)[8]) { v[0] = bflo(w.x); v[1] = bfhi(w.x); v[2] = bflo(w.y); v[3] = bfhi(w.y); v[4] = bflo(w.z); v[5] = bfhi(w.z); v[6] = bflo(w.w); v[7] = bfhi(w.w); }
__device__ __forceinline__ u32x4 pack8(const float (&v)[8]) { u32x4 w; w.x = pk2(v[0], v[1]); w.y = pk2(v[2], v[3]); w.z = pk2(v[4], v[5]); w.w = pk2(v[6], v[7]); return w; }
#define DPP_F(v, ctrl) __builtin_bit_cast(float, __builtin_amdgcn_update_dpp(0, __builtin_bit_cast(int, (v)), (ctrl), 0xF, 0xF, true))
__device__ __forceinline__ float wave_sum(float v) {
    v += DPP_F(v, 0xB1); v += DPP_F(v, 0x4E); v += DPP_F(v, 0x141); v += DPP_F(v, 0x140);
    return pg8::xrow_sum(v);
}

__device__ __forceinline__ float wave_max(float v) {
    v = fmaxf(v, DPP_F(v, 0xB1)); v = fmaxf(v, DPP_F(v, 0x4E)); v = fmaxf(v, DPP_F(v, 0x141)); v = fmaxf(v, DPP_F(v, 0x140));
    return pg8::xrow_max(v);
}
__device__ __forceinline__ unsigned q4(float a, float b, float c, float d, float inv) {
    const int qa = (int)__builtin_rintf(a * inv), qb = (int)__builtin_rintf(b * inv), qc = (int)__builtin_rintf(c * inv), qd = (int)__builtin_rintf(d * inv);
    return (unsigned)(qa & 255) | ((unsigned)(qb & 255) << 8) | ((unsigned)(qc & 255) << 16) | ((unsigned)qd << 24);
}
__device__ __forceinline__ void ld_row16_bf16(const bf16_t* xrow, int lane, u32x4 (&w)[8]) { const GAS u32x4* xr = (const GAS u32x4*)xrow + 2 * lane;
#pragma unroll
    for (int j = 0; j < 4; ++j) { w[2 * j] = xr[128 * j]; w[2 * j + 1] = xr[128 * j + 1]; } }
__device__ __forceinline__ void unpack16(const u32x4 a, const u32x4 b, float (&v)[16]) {
    v[0] = bflo(a.x); v[1] = bfhi(a.x); v[2] = bflo(a.y); v[3] = bfhi(a.y); v[4] = bflo(a.z); v[5] = bfhi(a.z); v[6] = bflo(a.w); v[7] = bfhi(a.w);
    v[8] = bflo(b.x); v[9] = bfhi(b.x); v[10] = bflo(b.y); v[11] = bfhi(b.y); v[12] = bflo(b.z); v[13] = bfhi(b.z); v[14] = bflo(b.w); v[15] = bfhi(b.w); }
__device__ __forceinline__ void unpack16h(const u32x4 a, const u32x4 b, float (&v)[16]) {
    v[0] = pg8::hlo(a.x); v[1] = pg8::hhi(a.x); v[2] = pg8::hlo(a.y); v[3] = pg8::hhi(a.y); v[4] = pg8::hlo(a.z); v[5] = pg8::hhi(a.z); v[6] = pg8::hlo(a.w); v[7] = pg8::hhi(a.w);
    v[8] = pg8::hlo(b.x); v[9] = pg8::hhi(b.x); v[10] = pg8::hlo(b.y); v[11] = pg8::hhi(b.y); v[12] = pg8::hlo(b.z); v[13] = pg8::hhi(b.z); v[14] = pg8::hlo(b.w); v[15] = pg8::hhi(b.w); }
__device__ __forceinline__ void quant_row_store(const float (&h)[4][16], int lane, unsigned char* qrow, float* srow) {
    float mx = 0.f;
#pragma unroll
    for (int j = 0; j < 4; ++j)
#pragma unroll
        for (int e = 0; e < 16; ++e) mx = fmaxf(mx, fabsf(h[j][e]));
    mx = wave_max(mx);
    const float inv = mx > 0.f ? 127.0f / mx : 0.f;
#pragma unroll
    for (int j = 0; j < 4; ++j) { u32x4 w; w.x = q4(h[j][0], h[j][1], h[j][2], h[j][3], inv); w.y = q4(h[j][4], h[j][5], h[j][6], h[j][7], inv); w.z = q4(h[j][8], h[j][9], h[j][10], h[j][11], inv); w.w = q4(h[j][12], h[j][13], h[j][14], h[j][15], inv);
        *(GAS u32x4*)(qrow + 16 * (64 * j + lane)) = w; }
    if (lane == 0) *srow = mx * (1.0f / 127.0f);
}
__device__ __forceinline__ float quad_xor1(float v) { return __builtin_bit_cast(float, __builtin_amdgcn_update_dpp(0, __builtin_bit_cast(int, v), 0xB1, 0xF, 0xF, true)); }
__device__ __forceinline__ float quad_xor2(float v) { return __builtin_bit_cast(float, __builtin_amdgcn_update_dpp(0, __builtin_bit_cast(int, v), 0x4E, 0xF, 0xF, true)); }
__device__ __forceinline__ void hadamard64_row(float (&h)[4][16], int lane) {
#pragma unroll
    for (int j = 0; j < 4; ++j) {
#pragma unroll
        for (int s = 1; s < 16; s <<= 1)
#pragma unroll
            for (int i = 0; i < 16; ++i) if ((i & s) == 0) { const float a = h[j][i], b = h[j][i + s]; h[j][i] = a + b; h[j][i + s] = a - b; }
#pragma unroll
        for (int bit = 1; bit <= 2; bit <<= 1)
#pragma unroll
            for (int i = 0; i < 16; ++i) { const float p = (bit == 1) ? quad_xor1(h[j][i]) : quad_xor2(h[j][i]); h[j][i] = (lane & bit) ? (p - h[j][i]) : (h[j][i] + p); }
#pragma unroll
        for (int i = 0; i < 16; ++i) h[j][i] *= 0.125f;
    }
}
constexpr bool ROT5 = true;
constexpr bool ROT7 = true;
__device__ __forceinline__ void quant_wrow(const u32x4 (&w)[8], int lane, unsigned char* qrow, float* srow, bool rot = false) {
    float h[4][16];
#pragma unroll
    for (int j = 0; j < 4; ++j) unpack16(w[2 * j], w[2 * j + 1], h[j]);
    if (rot) hadamard64_row(h, lane);
    quant_row_store(h, lane, qrow, srow);
}

__device__ __forceinline__ void requant_r8_row(const unsigned char* src, const float* cs, int lane, unsigned char* qrow, float& scale) {
    float s[16]; float mx = 0.f;
#pragma unroll
    for (int j = 0; j < 16; ++j) { s[j] = *(const GAS float*)(cs + 16 * j + (lane >> 2)); mx = fmaxf(mx, s[j]); }
    mx = wave_max(mx);
    const float rm = 255.0f * mx, hm = rm * rm, inv = hm > 0.f ? 255.0f / hm : 0.f;
    const GAS u32x4* p = (const GAS u32x4*)src + lane;
#pragma unroll 1
    for (int j0 = 0; j0 < 16; j0 += 8) { u32x4 w[8];
#pragma unroll
        for (int j = 0; j < 8; ++j) w[j] = p[64 * (j0 + j)];
#pragma unroll
        for (int j = 0; j < 8; ++j) { const float sj = (j0 == 0) ? s[j] : s[8 + j], cj = sj * sj * inv; unsigned o[4];
#pragma unroll
            for (int d = 0; d < 4; ++d) { float q[4];
#pragma unroll
                for (int e = 0; e < 4; ++e) { const float t = (float)((w[j][d] >> (8 * e)) & 255u); q[e] = t * t; }
                o[d] = pg8::pack4_rne(q[0], q[1], q[2], q[3], cj) ^ 0x80808080u; }
            *(GAS u32x4*)(qrow + 16 * (64 * (j0 + j) + lane)) = (u32x4){o[0], o[1], o[2], o[3]}; } }
    scale = hm * (1.0f / 255.0f);
}
template <bool UNS> __device__ __forceinline__ void quant_wide_row(const bf16_t* src, int lane, unsigned char* qrow, float& scale, int& qsum, float given_max = -1.f) {
    const GAS u32x4* p = (const GAS u32x4*)src + 2 * lane;
    float mx = 0.f;
    if (given_max >= 0.f) mx = given_max;
    else
#pragma unroll 1
    for (int j0 = 0; j0 < 16; j0 += 8) { u32x4 w[16];
#pragma unroll
        for (int j = 0; j < 8; ++j) { w[2 * j] = p[128 * (j0 + j)]; w[2 * j + 1] = p[128 * (j0 + j) + 1]; }
#pragma unroll
        for (int j = 0; j < 8; ++j) { float v[16]; unpack16(w[2 * j], w[2 * j + 1], v);
#pragma unroll
            for (int e = 0; e < 16; ++e) mx = fmaxf(mx, fabsf(v[e])); } }
    if (given_max < 0.f) mx = wave_max(mx);
    const float lev = UNS ? 255.0f : 127.0f, inv = mx > 0.f ? lev / mx : 0.f;
    int isum = 0;
#pragma unroll 1
    for (int j0 = 0; j0 < 16; j0 += 8) { u32x4 w[16];
#pragma unroll
        for (int j = 0; j < 8; ++j) { w[2 * j] = p[128 * (j0 + j)]; w[2 * j + 1] = p[128 * (j0 + j) + 1]; }
#pragma unroll
        for (int j = 0; j < 8; ++j) { float v[16]; unpack16(w[2 * j], w[2 * j + 1], v); unsigned o[4];
#pragma unroll
            for (int d = 0; d < 4; ++d) { unsigned pk = 0u;
#pragma unroll
                for (int e = 0; e < 4; ++e) { const int q = (int)fminf(__builtin_rintf(v[4 * d + e] * inv), lev) - (UNS ? 128 : 0); isum += q; pk |= (unsigned)(q & 255) << (8 * e); }
                o[d] = pk; }
            *(GAS u32x4*)(qrow + 16 * (64 * (j0 + j) + lane)) = (u32x4){o[0], o[1], o[2], o[3]}; } }
#pragma unroll
    for (int o = 1; o < 64; o <<= 1) isum += __shfl_xor(isum, o);
    scale = mx / lev; qsum = isum;
}

#define XB_TMO      128
#define XB_XCNT(j)  (256  + 64 * (j))
#define XB_XSUB(j)  (1280 + 64 * (j))
#define XB_XGEN(j)  (2304 + 64 * (j))
#define XB_TOP      3328
#define XB_TOPGEN   3392
#define XCD_BAR_WORDS 3456
#define XB_SPIN_CAP (1u << 18)

__device__ __forceinline__ unsigned xb_ld(unsigned* p)              { return __hip_atomic_load(p, __ATOMIC_RELAXED, __HIP_MEMORY_SCOPE_AGENT); }
__device__ __forceinline__ unsigned xb_add(unsigned* p, unsigned v) { return __hip_atomic_fetch_add(p, v, __ATOMIC_RELAXED, __HIP_MEMORY_SCOPE_AGENT); }
__device__ __forceinline__ unsigned xb_xcc_id() { return (unsigned)__builtin_amdgcn_s_getreg((3 << 11) | 20) & 0xFu; }
#define XB_SPIN(cond, bar) do { unsigned _sp = 0; while (cond) { __builtin_amdgcn_s_sleep(1); \
    if ((++_sp & 255u) == 0u) { if (xb_ld(&(bar)[XB_TMO])) break; if (_sp > XB_SPIN_CAP) { atomicAdd(&(bar)[XB_TMO], 1u); break; } } } } while (0)

struct XcdBarrier {
    unsigned* bar; unsigned x;
    volatile LAS unsigned* st;
};
__device__ __forceinline__ XcdBarrier xcd_barrier_post(unsigned* bar, volatile LAS unsigned* st) {
    XcdBarrier b; b.bar = bar; b.x = xb_xcc_id(); b.st = st;
    if (threadIdx.x == 0) (void)xb_add(&bar[XB_XCNT(b.x)], 1u);
    return b;
}
__device__ __forceinline__ void xcd_barrier_complete(unsigned* bar, unsigned x, unsigned& nloc, unsigned& nx) {
    const unsigned G = gridDim.x * gridDim.y * gridDim.z;
    unsigned sum, cnt, mine, sp = 0u;
    for (;;) {
        sum = 0u; cnt = 0u; mine = 0u;
#pragma unroll
        for (unsigned j = 0; j < 16; ++j) { const unsigned c = xb_ld(&bar[XB_XCNT(j)]); sum += c; cnt += (c > 0u) ? 1u : 0u; mine = (j == x) ? c : mine; }
        if (sum == G) break;
        __builtin_amdgcn_s_sleep(1);
        if ((++sp & 255u) == 0u) { if (xb_ld(&bar[XB_TMO])) break; if (sp > XB_SPIN_CAP) { atomicAdd(&bar[XB_TMO], 1u); break; } }
    }
    nloc = mine > 0u ? mine : 1u; nx = cnt > 0u ? cnt : 1u;
}
__device__ __forceinline__ void xcd_barrier(const XcdBarrier& b) {
    asm volatile("s_waitcnt vmcnt(0)" ::: "memory");
    __syncthreads();
    if (threadIdx.x == 0) {
        unsigned* bar = b.bar;
        __builtin_amdgcn_s_waitcnt(0);
        unsigned nloc = b.st[0], nx = b.st[1];
        if (nloc == 0u) { xcd_barrier_complete(bar, b.x, nloc, nx); b.st[0] = nloc; b.st[1] = nx; }
        const unsigned old = xb_add(&bar[XB_XSUB(b.x)], 1u);
        const unsigned gen = old / nloc;
        if (old + 1u == (gen + 1u) * nloc) {
            __builtin_amdgcn_fence(__ATOMIC_RELEASE, "agent");
            asm volatile("s_waitcnt vmcnt(0)" ::: "memory");
            const unsigned og = xb_add(&bar[XB_TOP], 1u);
            const unsigned tg = og / nx;
            if (og + 1u == (tg + 1u) * nx) xb_add(&bar[XB_TOPGEN], 1u);
            else XB_SPIN(xb_ld(&bar[XB_TOPGEN]) == tg, bar);
            __builtin_amdgcn_fence(__ATOMIC_ACQUIRE, "agent");
            xb_add(&bar[XB_XGEN(b.x)], 1u);
            asm volatile("s_waitcnt vmcnt(0)" ::: "memory");
        } else {
            XB_SPIN(xb_ld(&bar[XB_XGEN(b.x)]) == gen, bar);
            __builtin_amdgcn_fence(__ATOMIC_ACQUIRE, "agent");
            asm volatile("s_waitcnt vmcnt(0)" ::: "memory");
        }
    }
    __syncthreads();
}

struct Args { const float* in[17]; float* out; unsigned char* ws; };
struct Frame {
    LAS unsigned char* lds;
    int tid, lane, wave, G, bx;
    const float *x, *c, *w_ada, *b_ada, *g1, *w_in, *pool_mix_w, *pool_scale, *conv_w, *conv_b, *gpool, *gconv, *w_out, *g2, *w1, *w2, *gfin;
    float* out;
    float *modpart, *modfull, *statsp, *stats1, *stats2;
    bf16_t *MixT, *WinT, *WoutT, *W1T, *W2T, *HB, *HID, *PROJ, *MIXED, *POOLED, *X1B;
    unsigned char *W1Q, *WoutQ, *H2Q, *MIXQ, *H1Q, *WinQ, *HIDQ, *W2Q; float *sA8, *sB2; int* cs2; unsigned* hmax; float *sBout, *sB1, *sA5, *sA7, *sA1, *sBin;
};

__device__ __forceinline__ void p0_ada_item(const Frame& F, int item) {
    const int cb = item % 96, ks = item / 96;
    const int k0 = ks * 512 + F.wave * 64, col = cb * 256 + F.lane * 4;
    float sv[4];
#pragma unroll
    for (int b = 0; b < 4; ++b) { const float cv = F.c[b * D + k0 + F.lane]; sv[b] = cv / (1.0f + expf(-cv)); }
    f32x4 acc[4];
#pragma unroll
    for (int b = 0; b < 4; ++b) acc[b] = (f32x4){0.f, 0.f, 0.f, 0.f};
    const GAS f32x4* wp = (const GAS f32x4*)(F.w_ada + (size_t)k0 * NMODW + col);
#pragma unroll 32
    for (int kk = 0; kk < 64; ++kk) {
        const f32x4 w = wp[(size_t)kk * (NMODW / 4)];
#pragma unroll
        for (int b = 0; b < 4; ++b) { const float s = __builtin_bit_cast(float, __builtin_amdgcn_readlane(__builtin_bit_cast(int, sv[b]), kk)); acc[b] += w * s; }
    }
    LAS float* red = (LAS float*)F.lds;
#pragma unroll
    for (int b = 0; b < 4; ++b) *(LAS f32x4*)(red + (F.wave * 4 + b) * 256 + F.lane * 4) = acc[b];
    __syncthreads();
#pragma unroll
    for (int h = 0; h < 2; ++h) { const int o = F.tid + h * 512, b = o >> 8, cc = o & 255; float s = 0.f;
#pragma unroll
        for (int w = 0; w < 8; ++w) s += red[(w * 4 + b) * 256 + cc];
        const int n = cb * 256 + cc;
        if (ks == 0) s += F.b_ada[n];
        F.modpart[(size_t)(ks * 4 + b) * NMODW + n] = s; }
    __syncthreads();
}
struct TItem { const float* W; bf16_t* WT; int K, N, r, perm; };
__device__ __forceinline__ void p0_titem_load(const TItem& t, int lane, f32x4 (&v)[8]) {
    const int nblk = t.N / 32, kb = t.r / nblk, nb = t.r % nblk, k0 = 64 * kb, n0 = 32 * nb;
    const GAS float* src = (const GAS float*)t.W + (size_t)(k0 + (lane >> 3)) * t.N + n0 + 4 * (lane & 7);
#pragma unroll
    for (int i = 0; i < 8; ++i) v[i] = *(const GAS f32x4*)(src + (size_t)(8 * i) * t.N);
}
__device__ __forceinline__ void p0_titem_store(const TItem& t, int lane, const f32x4 (&v)[8], LAS float* scr) {
    const int nblk = t.N / 32, kb = t.r / nblk, nb = t.r % nblk, k0 = 64 * kb, n0 = 32 * nb;
#pragma unroll
    for (int i = 0; i < 8; ++i)
#pragma unroll
        for (int e = 0; e < 4; ++e) scr[(8 * i + (lane >> 3)) * 33 + 4 * (lane & 7) + e] = v[i][e];
    LDS_WAIT(); asm volatile("" ::: "memory");
    const int c = lane & 7;
    int n0d = n0;
    if (t.perm && n0 >= 2 * PW) { const int isu = n0 >= 3 * PW, ch = n0 - (isu ? 3 * PW : 2 * PW); n0d = 2 * PW + 256 * (ch >> 7) + 128 * isu + (ch & 127); }
#pragma unroll
    for (int j = 0; j < 4; ++j) { const int n = (lane >> 3) + 8 * j; const LAS float* s = scr + (8 * c) * 33 + n;
        u32x4 o; o.x = pk2(s[0 * 33], s[1 * 33]); o.y = pk2(s[2 * 33], s[3 * 33]); o.z = pk2(s[4 * 33], s[5 * 33]); o.w = pk2(s[6 * 33], s[7 * 33]);
        *(GAS u32x4*)(t.WT + (size_t)(n0d + n) * t.K + k0 + 8 * c) = o; }
    LDS_WAIT(); asm volatile("" ::: "memory");
}
__device__ __forceinline__ TItem p0_titem(const Frame& F, int it) {
    constexpr int I_IN = (D / 64) * (NPROJ / 32), I_OUT = (D / 64) * (D / 32), I_1 = (D / 64) * (FF / 32), I_2 = (FF / 64) * (D / 32), I_MIX = (PGD / 64) * (PGD / 32);
    int r = it;
    if (r < I_IN) return TItem{F.w_in, F.WinT, D, NPROJ, r, 1}; r -= I_IN;
    if constexpr (!PANEL_P0) {
    if (r < I_OUT) return TItem{F.w_out, F.WoutT, D, D, r, 0}; r -= I_OUT;
    if (r < I_1) return TItem{F.w1, F.W1T, D, FF, r, 0}; r -= I_1; }
    if (r < I_2) return TItem{F.w2, F.W2T, FF, D, r, 0}; r -= I_2;
    const int g = r / I_MIX; r -= g * I_MIX;
    return TItem{F.pool_mix_w + (size_t)g * PGD * PGD, F.MixT + (size_t)g * PGD * PGD, PGD, PGD, r, 0};
}
constexpr int PANEL_PITCH = 8208;
__device__ __forceinline__ int panel_row_off(int n) { return n * PANEL_PITCH + (n == 15 ? (RING_BYTES + 1024) - 15 * PANEL_PITCH : 0); }
struct Panel { const float* W; int N, n0; unsigned char* Q; float* sc; bool rot; };
__device__ __forceinline__ Panel p0_panel_of(const Frame& F, int p) {
    if (p < D / 16) return Panel{F.w_out, D, 16 * p, F.WoutQ, F.sBout, ROT5};
    return Panel{F.w1, FF, 16 * (p - D / 16), F.W1Q, F.sB1, ROT7};
}
__device__ __forceinline__ void p0_panels(const Frame& F, int first, int step, int npan) {
    if (first >= npan) return;
    const int r = F.lane >> 2, c4 = F.lane & 3;
    int woff[4];
#pragma unroll
    for (int e = 0; e < 4; ++e) woff[e] = panel_row_off(4 * c4 + e) + (512 * F.wave + 2 * r) * 2;
    f32x4 va[2][4], vb[2][4];
#define P0C_SRC(pn) ((const GAS float*)(pn).W + (size_t)(512 * F.wave + 2 * r) * (pn).N + (pn).n0 + 4 * c4)
#define P0C_LOAD(buf, b, s, N_) do { _Pragma("unroll") for (int t = 0; t < 4; ++t) { va[buf][t] = *(const GAS f32x4*)((s) + (size_t)(32 * (4 * (b) + t)) * (N_)); vb[buf][t] = *(const GAS f32x4*)((s) + (size_t)(32 * (4 * (b) + t) + 1) * (N_)); } } while (0)
#define P0C_PUT(buf, b) do { _Pragma("unroll") for (int t = 0; t < 4; ++t) _Pragma("unroll") for (int e = 0; e < 4; ++e) *(LAS unsigned*)(F.lds + woff[e] + 64 * (4 * (b) + t)) = pk2(va[buf][t][e], vb[buf][t][e]); } while (0)
    int p = first;
    { const Panel cur = p0_panel_of(F, p); const GAS float* s = P0C_SRC(cur); P0C_LOAD(0, 0, s, cur.N); P0C_LOAD(1, 1, s, cur.N); }
    for (;;) {
        const Panel cur = p0_panel_of(F, p);
        { const GAS float* s = P0C_SRC(cur); P0C_PUT(0, 0); P0C_LOAD(0, 2, s, cur.N); P0C_PUT(1, 1); P0C_LOAD(1, 3, s, cur.N); P0C_PUT(0, 2); P0C_PUT(1, 3); }
        __syncthreads();
        const int pn = p + step; const bool has = pn < npan;
        if (has) { const Panel nx = p0_panel_of(F, pn); const GAS float* s = P0C_SRC(nx); P0C_LOAD(0, 0, s, nx.N); P0C_LOAD(1, 1, s, nx.N); }
#pragma unroll 1
        for (int q = 0; q < 2; ++q) { const int n = 2 * F.wave + q; const LAS unsigned char* rowp = F.lds + panel_row_off(n) + 32 * F.lane; u32x4 w[8];
#pragma unroll
            for (int j = 0; j < 4; ++j) { w[2 * j] = *(const LAS u32x4*)(rowp + 2048 * j); w[2 * j + 1] = *(const LAS u32x4*)(rowp + 2048 * j + 16); }
            quant_wrow(w, F.lane, cur.Q + (size_t)(cur.n0 + n) * D, cur.sc + cur.n0 + n, cur.rot); }
        __syncthreads();
        if (!has) break;
        p = pn;
    }
#undef P0C_SRC
#undef P0C_LOAD
#undef P0C_PUT
}
__device__ __forceinline__ void p0_prologue(const Frame& F) {
    for (int item = F.bx; item < 96 * 8; item += F.G) p0_ada_item(F, item);
    __syncthreads();
    if constexpr (PANEL_P0) {
        constexpr int NPAN = D / 16 + FF / 16;
        const bool paired = (F.G & 15) == 0;
        const int PP = (NPAN / 2 + F.G / 2 - 1) / (F.G / 2), q = (F.bx & 7) + 8 * (F.bx >> 4);
        const int first = paired ? 2 * (q * PP) + ((F.bx >> 3) & 1) : F.bx, step = paired ? 2 : F.G, last = paired ? (2 * (q * PP + PP) < NPAN ? 2 * (q * PP + PP) : NPAN) : NPAN;
        p0_panels(F, first, step, last);
    }
    LAS float* scr = (LAS float*)(F.lds + F.wave * 16384);
    const int gw = F.bx * NWAVES + F.wave, NGW = F.G * NWAVES;
    constexpr int NITEMS = (D / 64) * (NPROJ / 32) + (PANEL_P0 ? 0 : (D / 64) * (D / 32) + (D / 64) * (FF / 32)) + (FF / 64) * (D / 32) + 4 * (PGD / 64) * (PGD / 32);
    int it = gw;
    if (it < NITEMS) {
        TItem cur = p0_titem(F, it); f32x4 v[8]; p0_titem_load(cur, F.lane, v);
        for (;;) {
            const int nit = it + NGW; const bool has = nit < NITEMS;
            TItem nx = cur; f32x4 vn[8];
            if (has) { nx = p0_titem(F, nit); p0_titem_load(nx, F.lane, vn); }
            p0_titem_store(cur, F.lane, v, scr);
            if (!has) break;
            cur = nx; it = nit;
#pragma unroll
            for (int i = 0; i < 8; ++i) v[i] = vn[i];
        }
    }
}

__device__ __forceinline__ void ld_row_f32(const float* xrow, int lane, f32x4 (&v)[16]) { const GAS f32x4* xr = (const GAS f32x4*)xrow + 2 * lane;
#pragma unroll
    for (int j = 0; j < 8; ++j) { v[2 * j] = xr[128 * j]; v[2 * j + 1] = xr[128 * j + 1]; } }
__device__ __forceinline__ void ld_row_bf16(const bf16_t* xrow, int lane, u32x4 (&w)[8]) { const GAS u32x4* xr = (const GAS u32x4*)xrow + lane;
#pragma unroll
    for (int j = 0; j < 8; ++j) w[j] = xr[64 * j]; }
__device__ __forceinline__ void norm_mod_finish_f32(const f32x4 (&v)[16], int lane, bf16_t* orow, const LAS float* av, const LAS float* sv) {
    float ss = 0.f;
#pragma unroll
    for (int j = 0; j < 16; ++j) ss += (v[j][0] * v[j][0] + v[j][1] * v[j][1]) + (v[j][2] * v[j][2] + v[j][3] * v[j][3]);
    ss = wave_sum(ss);
    const float rs = 1.0f / sqrtf(ss * (1.0f / D) + EPS);
    GAS u32x4* o16 = (GAS u32x4*)orow + lane;
#pragma unroll
    for (int j = 0; j < 8; ++j) { const int col = 8 * (64 * j + lane);
        const f32x4 a0 = *(const LAS f32x4*)(av + col), a1 = *(const LAS f32x4*)(av + col + 4), s0 = *(const LAS f32x4*)(sv + col), s1 = *(const LAS f32x4*)(sv + col + 4);
        const f32x4 o0 = v[2 * j] * rs * a0 + s0, o1 = v[2 * j + 1] * rs * a1 + s1;
        u32x4 w; w.x = pk2(o0[0], o0[1]); w.y = pk2(o0[2], o0[3]); w.z = pk2(o1[0], o1[1]); w.w = pk2(o1[2], o1[3]); o16[64 * j] = w; }
}
__device__ __forceinline__ void norm_mod_finish_bf16(const u32x4 (&w)[8], int lane, bf16_t* orow, const LAS float* av, const LAS float* sv, float ss) {
    const float rs = 1.0f / sqrtf(ss * (1.0f / D) + EPS);
    GAS u32x4* o16 = (GAS u32x4*)orow + lane;
#pragma unroll
    for (int j = 0; j < 8; ++j) { const int col = 8 * (64 * j + lane); float v[8]; unpack8(w[j], v);
        const f32x4 a0 = *(const LAS f32x4*)(av + col), a1 = *(const LAS f32x4*)(av + col + 4), s0 = *(const LAS f32x4*)(sv + col), s1 = *(const LAS f32x4*)(sv + col + 4);
#pragma unroll
        for (int e = 0; e < 4; ++e) { v[e] = v[e] * rs * a0[e] + s0[e]; v[4 + e] = v[4 + e] * rs * a1[e] + s1[e]; }
        o16[64 * j] = pack8(v); }
}

__device__ __forceinline__ void ld_row16_f32(const float* xrow, int lane, f32x4 (&v)[16]) { const GAS f32x4* xr = (const GAS f32x4*)xrow + 4 * lane;
#pragma unroll
    for (int j = 0; j < 4; ++j)
#pragma unroll
        for (int i = 0; i < 4; ++i) v[4 * j + i] = xr[256 * j + i]; }
__device__ __forceinline__ void st_row16_bf16(const float (&h)[4][16], int lane, bf16_t* orow) { GAS u32x4* o16 = (GAS u32x4*)orow + 2 * lane;
#pragma unroll
    for (int j = 0; j < 4; ++j) { u32x4 a, b; a.x = pk2(h[j][0], h[j][1]); a.y = pk2(h[j][2], h[j][3]); a.z = pk2(h[j][4], h[j][5]); a.w = pk2(h[j][6], h[j][7]);
        b.x = pk2(h[j][8], h[j][9]); b.y = pk2(h[j][10], h[j][11]); b.z = pk2(h[j][12], h[j][13]); b.w = pk2(h[j][14], h[j][15]); o16[128 * j] = a; o16[128 * j + 1] = b; } }

__device__ __forceinline__ void ld8(const bf16_t* p, float (&v)[8]) { const u32x4 w = *(const GAS u32x4*)p; unpack8(w, v); }
__device__ __forceinline__ void p3_pool_item(const Frame& F, int tt, int g) {
    const int row0 = tt * 32, b = row0 >> 12, t0 = row0 & (SEQ - 1), h = 1 << g;
    const bf16_t* base = F.PROJ + (size_t)(b * SEQ) * PJ + PGD * g + 8 * F.lane;
    bf16_t* obase = F.POOLED + (size_t)(b * SEQ) * PW + PGD * g + 8 * F.lane;
    float S[8];
#pragma unroll
    for (int e = 0; e < 8; ++e) S[e] = 0.f;
    const int jlo = (t0 - h) > 0 ? (t0 - h) : 0, jhi = (t0 + h) < SEQ ? (t0 + h) : SEQ;
    for (int j = jlo; j < jhi; ++j) { float v[8]; ld8(base + (size_t)j * PJ, v);
#pragma unroll
        for (int e = 0; e < 8; ++e) S[e] += v[e]; }
#pragma unroll 8
    for (int i = 0; i < 32; ++i) { const int t = t0 + i;
        const int lo = (t - h) > 0 ? (t - h) : 0, hi = (t + h) < SEQ ? (t + h) : SEQ; const float inv = 1.0f / (float)(hi - lo);
        float vt[8], va[8], vs[8];
        ld8(base + (size_t)t * PJ, vt);
        const int ta = (t + h) < SEQ ? (t + h) : (SEQ - 1), ts = (t - h) > 0 ? (t - h) : 0;
        const float ma = (t + h) < SEQ ? 1.f : 0.f, ms = (t - h) >= 0 ? 1.f : 0.f;
        ld8(base + (size_t)ta * PJ, va); ld8(base + (size_t)ts * PJ, vs);
        float o[8];
#pragma unroll
        for (int e = 0; e < 8; ++e) { o[e] = S[e] * inv - vt[e]; S[e] += ma * va[e] - ms * vs[e]; }
        *(GAS u32x4*)(obase + (size_t)t * PW) = pack8(o); }
}
__device__ __forceinline__ void p3_conv_item(const Frame& F, int tt, int q) {
    const int row0 = tt * 32, b = row0 >> 12, t0 = row0 & (SEQ - 1), ch = 512 * q + 8 * F.lane;
    const bf16_t* pb = F.PROJ + (size_t)(b * SEQ) * PJ + PW + ch; const bf16_t* pcu = pb + CW;
    bf16_t* obase = F.MIXED + (size_t)(b * SEQ) * D + PW + ch;
    float w0[8], w1[8], w2[8], bs[8], gn[8];
#pragma unroll
    for (int e = 0; e < 8; ++e) { w0[e] = F.conv_w[ch + e]; w1[e] = F.conv_w[CW + ch + e]; w2[e] = F.conv_w[2 * CW + ch + e]; bs[e] = F.conv_b[ch + e]; gn[e] = F.gconv[ch + e]; }
    float cup[8], cuc[8], cun[8];
    { const int tp = t0 > 0 ? t0 - 1 : 0; const float mp = t0 > 0 ? 1.f : 0.f;
      ld8(pcu + (size_t)tp * PJ, cup);
#pragma unroll
      for (int e = 0; e < 8; ++e) cup[e] *= mp;
      ld8(pcu + (size_t)t0 * PJ, cuc); }
#pragma unroll 8
    for (int i = 0; i < 32; ++i) { const int t = t0 + i; const int tn = (t + 1) < SEQ ? (t + 1) : (SEQ - 1); const float mn = (t + 1) < SEQ ? 1.f : 0.f;
        float bg[8];
        ld8(pcu + (size_t)tn * PJ, cun); ld8(pb + (size_t)t * PJ, bg);
        float o[8]; float ss = 0.f;
#pragma unroll
        for (int e = 0; e < 8; ++e) { cun[e] *= mn; const float cv = w0[e] * cup[e] + w1[e] * cuc[e] + w2[e] * cun[e] + bs[e]; o[e] = bg[e] * cv; ss += o[e] * o[e]; cup[e] = cuc[e]; cuc[e] = cun[e]; }
        ss += DPP_F(ss, 0xB1); ss += DPP_F(ss, 0x4E); ss += DPP_F(ss, 0x141); ss += DPP_F(ss, 0x140);
        const float rs = 1.0f / sqrtf(ss * (1.0f / 128.0f) + EPS);
#pragma unroll
        for (int e = 0; e < 8; ++e) o[e] = o[e] * rs * gn[e];
        *(GAS u32x4*)(obase + (size_t)t * D) = pack8(o); }
}

__device__ __forceinline__ void relaunder(Frame& F) { int t = F.tid; asm volatile("" : "+v"(t)); F.tid = t; F.lane = t & 63; }
__global__ void __launch_bounds__(NWAVES * 64, 2) fwd_kernel(Args args) {
    extern __shared__ __attribute__((aligned(16))) unsigned char lds_raw[];
    Frame F;
    F.lds = (LAS unsigned char*)lds_raw;
    F.tid = threadIdx.x; F.lane = F.tid & 63; F.wave = __builtin_amdgcn_readfirstlane(F.tid >> 6);
    F.G = gridDim.x; F.bx = blockIdx.x;
    unsigned char* ws = args.ws;
    F.x = args.in[0]; F.c = args.in[1]; F.w_ada = args.in[2]; F.b_ada = args.in[3]; F.g1 = args.in[4]; F.w_in = args.in[5]; F.pool_mix_w = args.in[6]; F.pool_scale = args.in[7];
    F.conv_w = args.in[8]; F.conv_b = args.in[9]; F.gpool = args.in[10]; F.gconv = args.in[11]; F.w_out = args.in[12]; F.g2 = args.in[13]; F.w1 = args.in[14]; F.w2 = args.in[15]; F.gfin = args.in[16];
    F.out = args.out; F.X1B = (bf16_t*)args.out;
    F.modpart = (float*)(ws + WS_MODPART); F.modfull = (float*)(ws + WS_MODFULL); F.statsp = (float*)(ws + WS_STATSP); F.stats1 = (float*)(ws + WS_STATS1); F.stats2 = (float*)(ws + WS_STATS2);
    F.MixT = (bf16_t*)(ws + WS_MIXT); F.WinT = (bf16_t*)(ws + WS_WIN); F.WoutT = (bf16_t*)(ws + WS_WOUT); F.W1T = (bf16_t*)(ws + WS_W1); F.W2T = (bf16_t*)(ws + WS_W2);
    F.HB = (bf16_t*)(ws + WS_HB); F.HID = (bf16_t*)(ws + WS_HID); F.PROJ = (bf16_t*)(ws + WS_PROJ); F.MIXED = (bf16_t*)(ws + WS_MIXED); F.POOLED = (bf16_t*)(ws + WS_POOLED);
    F.W1Q = ws + WS_W1Q; F.WoutQ = ws + WS_WOUTQ; F.H2Q = (unsigned char*)args.out + 128 * MiB; F.MIXQ = ws + WS_MIXQ;
    F.HIDQ = ws + WS_HIDQ; F.W2Q = (unsigned char*)args.out + 192 * MiB; F.sA8 = (float*)(ws + WS_SA8); F.sB2 = (float*)(ws + WS_SB2); F.cs2 = (int*)(ws + WS_CS2); F.hmax = (unsigned*)(ws + WS_HMAX);
    F.H1Q = F.H2Q; F.WinQ = ws + WS_WINQ; F.sA1 = (float*)(ws + WS_SA1); F.sBin = (float*)(ws + WS_SBIN);
    F.sBout = (float*)(ws + WS_SBOUT); F.sB1 = (float*)(ws + WS_SB1); F.sA5 = (float*)(ws + WS_SA5); F.sA7 = (float*)(ws + WS_SA7);
    volatile LAS unsigned* MISC = (volatile LAS unsigned*)(F.lds + MISC_OFF);
    if (F.tid < 16) MISC[F.tid] = 0u;
    __syncthreads();
    XcdBarrier bar = xcd_barrier_post((unsigned*)(ws + WS_CTL), MISC);
    const int gw = F.bx * NWAVES + F.wave, NGW = F.G * NWAVES;
    LAS float* av = (LAS float*)F.lds;
    LAS float* sv = (LAS float*)(F.lds + 16384);

    relaunder(F);
    p0_prologue(F);
    xcd_barrier(bar);

    relaunder(F);
    for (int idx = F.bx * 512 + F.tid; idx < BATCH * NMODW; idx += F.G * 512) { float s = 0.f;
#pragma unroll
        for (int ks = 0; ks < 8; ++ks) s += F.modpart[(size_t)ks * BATCH * NMODW + idx];
        F.modfull[idx] = s; }
    for (int chunk = F.bx; chunk < M / 64; chunk += F.G) {
        const int b = chunk >> 6;
#pragma unroll
        for (int c4 = 0; c4 < 2; ++c4) { const int ci = 4 * (F.tid + 512 * c4); f32x4 sh = {0.f, 0.f, 0.f, 0.f}, sc = {0.f, 0.f, 0.f, 0.f};
#pragma unroll
            for (int ks = 0; ks < 8; ++ks) { const float* mp = F.modpart + (size_t)(ks * 4 + b) * NMODW; sh += *(const GAS f32x4*)(mp + ci); sc += *(const GAS f32x4*)(mp + D + ci); }
            *(LAS f32x4*)(av + ci) = *(const GAS f32x4*)(F.g1 + ci) * (1.0f + sc); *(LAS f32x4*)(sv + ci) = sh; }
        __syncthreads();
        { const int rbeg = chunk * 64 + F.wave * 8;
#pragma unroll 1
          for (int q = 0; q < 8; ++q) { const int row = rbeg + q;
              f32x4 v[16]; ld_row16_f32(F.x + (size_t)row * D, F.lane, v);
              float ss = 0.f;
#pragma unroll
              for (int j = 0; j < 16; ++j) ss += (v[j][0] * v[j][0] + v[j][1] * v[j][1]) + (v[j][2] * v[j][2] + v[j][3] * v[j][3]);
              const float rs = 1.0f / sqrtf(wave_sum(ss) * (1.0f / D) + EPS);
              float h[4][16];
#pragma unroll
              for (int j = 0; j < 4; ++j) { const int col = 16 * (64 * j + F.lane);
#pragma unroll
                  for (int e4 = 0; e4 < 4; ++e4) { const f32x4 a = *(const LAS f32x4*)(av + col + 4 * e4), s = *(const LAS f32x4*)(sv + col + 4 * e4);
#pragma unroll
                      for (int e = 0; e < 4; ++e) h[j][4 * e4 + e] = v[4 * j + e4][e] * rs * a[e] + s[e]; }
                  __builtin_amdgcn_sched_barrier(0); }
              st_row16_bf16(h, F.lane, F.HB + (size_t)row * D);
              if constexpr (NQ2 > 0) quant_row_store(h, F.lane, F.H1Q + (size_t)row * D, F.sA1 + row); } }
        __syncthreads();
    }
    if constexpr (NQ2 > 0) {
        for (int r = gw; r < 256 * NQ2; r += NGW) { u32x4 w[8]; ld_row16_bf16(F.WinT + (size_t)r * D, F.lane, w); quant_wrow(w, F.lane, F.WinQ + (size_t)r * D, F.sBin + r); } }
    xcd_barrier(bar);

    if constexpr (NQ2 > 0) { pg8::Gemm g{(const bf16_t*)F.H1Q, (const bf16_t*)F.WinQ, D / 2, D / 2, D / 2}; pg8::StaticOrder S; S.init(M, 256 * NQ2, F.G, F.bx);
      pg8::EpiProjI8 E{F.PROJ, F.sA1, F.sBin};
      pg8::gemm_phase<pg8::EpiProjI8, pg8::StaticOrder>(F.lds, g, S, E); }
    { pg8::Gemm g{F.HB, F.WinT + (size_t)256 * NQ2 * D, D, D, D}; pg8::StaticOrder S; S.init(M, NPROJ - 256 * NQ2, F.G, F.bx);
      pg8::EpiProj E{F.PROJ, NQ2};
      pg8::gemm_phase<pg8::EpiProj, pg8::StaticOrder>(F.lds, g, S, E); }
    xcd_barrier(bar);

    relaunder(F);
    for (int it = gw; it < 4096; it += NGW) {
        if (it < 2048) p3_pool_item(F, it >> 2, it & 3); else p3_conv_item(F, (it - 2048) >> 2, (it - 2048) & 3);
    }
    if constexpr (!PANEL_P0) { constexpr int RW5 = I8_P5 ? D : 0, RW = RW5 + 256 * NQ7;
      int r = gw; u32x4 wcur[8];
      if (r < RW) ld_row16_bf16((r < RW5) ? F.WoutT + (size_t)r * D : F.W1T + (size_t)(r - RW5) * D, F.lane, wcur);
#pragma unroll 1
      for (; r < RW; r += NGW) { const int rn = r + NGW; u32x4 wnx[8];
          if (rn < RW) ld_row16_bf16((rn < RW5) ? F.WoutT + (size_t)rn * D : F.W1T + (size_t)(rn - RW5) * D, F.lane, wnx);
          if (r < RW5) quant_wrow(wcur, F.lane, F.WoutQ + (size_t)r * D, F.sBout + r, ROT5); else quant_wrow(wcur, F.lane, F.W1Q + (size_t)(r - RW5) * D, F.sB1 + (r - RW5), ROT7);
          if (rn < RW) {
#pragma unroll
              for (int i = 0; i < 8; ++i) wcur[i] = wnx[i]; } } }
    if constexpr (I8_P8) {
        for (int r = gw; r < D; r += NGW) { float sc; int qs; quant_wide_row<false>(F.W2T + (size_t)r * FF, F.lane, F.W2Q + (size_t)r * FF, sc, qs);
            if (F.lane == 0) { F.sB2[r] = sc; F.cs2[r] = qs; } } }
    xcd_barrier(bar);

    { pg8::Gemm g{F.POOLED, F.MixT, PGD, PW, PGD}; pg8::StaticOrder S; S.init(M, PW, F.G, F.bx, 1, PGD);
      pg8::EpiPoolMix E{F.MIXED, D, F.pool_scale, F.statsp};
      pg8::gemm_phase<pg8::EpiPoolMix, pg8::StaticOrder>(F.lds, g, S, E); }
    xcd_barrier(bar);

    relaunder(F);
    if constexpr (I8_P5) {
    { float gp[2][16];
#pragma unroll
      for (int j = 0; j < 2; ++j)
#pragma unroll
          for (int e = 0; e < 16; ++e) gp[j][e] = F.gpool[16 * (64 * j + F.lane) + e];
      const int rows_per = M / NGW, rbeg = gw * rows_per;
      u32x4 wcur[8]; float stc = (F.lane < 32) ? F.statsp[(size_t)rbeg * 32 + F.lane] : 0.f; ld_row16_bf16(F.MIXED + (size_t)rbeg * D, F.lane, wcur);
#pragma unroll 1
      for (int q = 0; q < rows_per; ++q) { const int row = rbeg + q; u32x4 wnx[8]; float stn = 0.f;
          if (q + 1 < rows_per) { stn = (F.lane < 32) ? F.statsp[(size_t)(row + 1) * 32 + F.lane] : 0.f; ld_row16_bf16(F.MIXED + (size_t)(row + 1) * D, F.lane, wnx); }
          float s = stc; s += __shfl_xor(s, 1); s += __shfl_xor(s, 2); s += __shfl_xor(s, 4);
          float rsg[4];
#pragma unroll
          for (int g = 0; g < 4; ++g) { const float ssg = __builtin_bit_cast(float, __builtin_amdgcn_readlane(__builtin_bit_cast(int, s), 8 * g)); rsg[g] = 1.0f / sqrtf(ssg * (1.0f / PGD) + EPS); }
          float h[4][16];
#pragma unroll
          for (int j = 0; j < 4; ++j) unpack16(wcur[2 * j], wcur[2 * j + 1], h[j]);
#pragma unroll
          for (int j = 0; j < 2; ++j) { const float rs = (F.lane < 32) ? rsg[2 * j] : rsg[2 * j + 1];
#pragma unroll
              for (int e = 0; e < 16; ++e) h[j][e] = h[j][e] * rs * gp[j][e]; }
          if constexpr (ROT5) hadamard64_row(h, F.lane);
          quant_row_store(h, F.lane, F.MIXQ + (size_t)row * D, F.sA5 + row);
          if (q + 1 < rows_per) { stc = stn;
#pragma unroll
              for (int i = 0; i < 8; ++i) wcur[i] = wnx[i]; } } }
    } else {
    { float gp[4][8];
#pragma unroll
      for (int g = 0; g < 4; ++g)
#pragma unroll
          for (int e = 0; e < 8; ++e) gp[g][e] = F.gpool[PGD * g + 8 * F.lane + e];
      for (int row0 = gw * 8; row0 < M; row0 += 8 * NGW) {
          u32x4 w[8][4]; float st[8];
#pragma unroll
          for (int q = 0; q < 8; ++q) { const int row = row0 + q;
              if (row < M) { st[q] = (F.lane < 32) ? F.statsp[(size_t)row * 32 + F.lane] : 0.f; const bf16_t* p = F.MIXED + (size_t)row * D + 8 * F.lane;
#pragma unroll
                  for (int g = 0; g < 4; ++g) w[q][g] = *(const GAS u32x4*)(p + PGD * g); } }
#pragma unroll
          for (int q = 0; q < 8; ++q) { const int row = row0 + q;
              if (row < M) { float s = st[q]; s += __shfl_xor(s, 1); s += __shfl_xor(s, 2); s += __shfl_xor(s, 4);
                  bf16_t* p = F.MIXED + (size_t)row * D + 8 * F.lane;
#pragma unroll
                  for (int g = 0; g < 4; ++g) { const float ssg = __builtin_bit_cast(float, __builtin_amdgcn_readlane(__builtin_bit_cast(int, s), 8 * g));
                      const float rs = 1.0f / sqrtf(ssg * (1.0f / PGD) + EPS);
                      float v[8]; unpack8(w[q][g], v);
#pragma unroll
                      for (int e = 0; e < 8; ++e) v[e] = v[e] * rs * gp[g][e];
                      *(GAS u32x4*)(p + PGD * g) = pack8(v); } } } } }
    }
    xcd_barrier(bar);

    if constexpr (I8_P5) { pg8::Gemm g{(const bf16_t*)F.MIXQ, (const bf16_t*)F.WoutQ, D / 2, D / 2, D / 2}; pg8::StaticOrder S; S.init(M, D, F.G, F.bx);
      pg8::EpiResidI8 E{F.x, F.X1B, F.modfull + 2 * D, F.stats1, F.sA5, F.sBout};
      pg8::gemm_phase<pg8::EpiResidI8, pg8::StaticOrder>(F.lds, g, S, E); }
    else { pg8::Gemm g{F.MIXED, F.WoutT, D, D, D}; pg8::StaticOrder S; S.init(M, D, F.G, F.bx);
      pg8::EpiResid<false> E{F.x, F.X1B, F.modfull + 2 * D, F.stats1};
      pg8::gemm_phase<pg8::EpiResid<false>, pg8::StaticOrder>(F.lds, g, S, E); }
    xcd_barrier(bar);

    relaunder(F);
    for (int chunk = F.bx; chunk < M / 64; chunk += F.G) {
        const int b = chunk >> 6; const float* mp = F.modfull + (size_t)b * NMODW;
#pragma unroll
        for (int c4 = 0; c4 < 2; ++c4) { const int ci = 4 * (F.tid + 512 * c4);
            *(LAS f32x4*)(av + ci) = *(const GAS f32x4*)(F.g2 + ci) * (1.0f + *(const GAS f32x4*)(mp + 4 * D + ci)); *(LAS f32x4*)(sv + ci) = *(const GAS f32x4*)(mp + 3 * D + ci); }
        __syncthreads();
        { const int rbeg = chunk * 64 + F.wave * 8;
          u32x4 wcur[8]; float stc = F.stats1[(size_t)rbeg * 64 + F.lane]; ld_row16_bf16(F.X1B + (size_t)rbeg * D, F.lane, wcur);
#pragma unroll 1
          for (int q = 0; q < 8; ++q) { const int row = rbeg + q; u32x4 wnx[8]; float stn = 0.f;
              if (q + 1 < 8) { stn = F.stats1[(size_t)(row + 1) * 64 + F.lane]; ld_row16_bf16(F.X1B + (size_t)(row + 1) * D, F.lane, wnx); }
              const float rs = 1.0f / sqrtf(wave_sum(stc) * (1.0f / D) + EPS);
              float h[4][16];
#pragma unroll
              for (int j = 0; j < 4; ++j) { unpack16h(wcur[2 * j], wcur[2 * j + 1], h[j]); const int col = 16 * (64 * j + F.lane);
#pragma unroll
                  for (int e4 = 0; e4 < 4; ++e4) { const f32x4 a = *(const LAS f32x4*)(av + col + 4 * e4), s = *(const LAS f32x4*)(sv + col + 4 * e4);
#pragma unroll
                      for (int e = 0; e < 4; ++e) h[j][4 * e4 + e] = h[j][4 * e4 + e] * rs * a[e] + s[e]; }
                  __builtin_amdgcn_sched_barrier(0); }
              if constexpr (NQ7 < 64) { GAS u32x4* o16 = (GAS u32x4*)(F.HB + (size_t)row * D) + 2 * F.lane;
#pragma unroll
                  for (int j = 0; j < 4; ++j) { u32x4 a, b; a.x = pk2(h[j][0], h[j][1]); a.y = pk2(h[j][2], h[j][3]); a.z = pk2(h[j][4], h[j][5]); a.w = pk2(h[j][6], h[j][7]);
                      b.x = pk2(h[j][8], h[j][9]); b.y = pk2(h[j][10], h[j][11]); b.z = pk2(h[j][12], h[j][13]); b.w = pk2(h[j][14], h[j][15]); o16[128 * j] = a; o16[128 * j + 1] = b; } }
              if constexpr (NQ7 > 0) { if constexpr (ROT7) hadamard64_row(h, F.lane); quant_row_store(h, F.lane, F.H2Q + (size_t)row * D, F.sA7 + row); }
              if (q + 1 < 8) { stc = stn;
#pragma unroll
                  for (int i = 0; i < 8; ++i) wcur[i] = wnx[i]; } } }
        __syncthreads();
    }
    xcd_barrier(bar);

    if constexpr (NQ7 > 0) { pg8::Gemm g{(const bf16_t*)F.H2Q, (const bf16_t*)F.W1Q, D / 2, D / 2, D / 2}; pg8::StaticOrder S; S.init(M, 256 * NQ7, F.G, F.bx);
      if constexpr (R8_HID) { pg8::EpiActR8 E{(unsigned char*)F.HID, FF, F.sA7, F.sB1, (float*)(ws + WS_CS8)};
          pg8::gemm_phase<pg8::EpiActR8, pg8::StaticOrder>(F.lds, g, S, E); }
      else { pg8::EpiActI8 E{F.HID, FF, F.sA7, F.sB1, I8_P8 ? F.hmax : nullptr};
          pg8::gemm_phase<pg8::EpiActI8, pg8::StaticOrder>(F.lds, g, S, E); } }
    if constexpr (NQ7 < 64) { pg8::Gemm g{F.HB, F.W1T + (size_t)256 * NQ7 * D, D, D, D}; pg8::StaticOrder S; S.init(M, FF - 256 * NQ7, F.G, F.bx);
      pg8::EpiBf16<1> E{F.HID + 256 * NQ7, FF, I8_P8 ? F.hmax : nullptr};
      pg8::gemm_phase<pg8::EpiBf16<1>, pg8::StaticOrder>(F.lds, g, S, E); }
    xcd_barrier(bar);

    if constexpr (I8_P8) {
        relaunder(F);
        if constexpr (R8_HID) { for (int r = gw; r < M; r += NGW) { float sc; requant_r8_row((const unsigned char*)F.HID + (size_t)r * FF, (const float*)(ws + WS_CS8) + (size_t)r * (FF / 64), F.lane, F.HIDQ + (size_t)r * FF, sc); if (F.lane == 0) F.sA8[r] = sc; } }
        else
        for (int r = gw; r < M; r += NGW) { float sc; int qs; const float rmax = __builtin_bit_cast(float, __builtin_amdgcn_readfirstlane(F.hmax[r])); quant_wide_row<true>(F.HID + (size_t)r * FF, F.lane, F.HIDQ + (size_t)r * FF, sc, qs, rmax); if (F.lane == 0) F.sA8[r] = sc; }
        xcd_barrier(bar);
    }

    if constexpr (I8_P8) { pg8::Gemm g{(const bf16_t*)F.HIDQ, (const bf16_t*)F.W2Q, FF / 2, FF / 2, FF / 2}; pg8::StaticOrder S; S.init(M, D, F.G, F.bx);
      pg8::EpiResidQ8 E{F.X1B, F.HB, F.modfull + 5 * D, F.stats2, F.sA8, F.sB2, F.cs2};
      pg8::gemm_phase<pg8::EpiResidQ8, pg8::StaticOrder>(F.lds, g, S, E); }
    else { pg8::Gemm g{F.HID, F.W2T, FF, FF, FF}; pg8::StaticOrder S; S.init(M, D, F.G, F.bx);
      pg8::EpiResid<true> E{F.X1B, F.HB, F.modfull + 5 * D, F.stats2};
      pg8::gemm_phase<pg8::EpiResid<true>, pg8::StaticOrder>(F.lds, g, S, E); }
    xcd_barrier(bar);

    relaunder(F);
    for (int row0 = gw * 4; row0 < M; row0 += 4 * NGW) {
        u32x4 w[4][8]; float st[4];
#pragma unroll
        for (int q = 0; q < 4; ++q) { const int row = row0 + q;
            if (row < M) { st[q] = F.stats2[(size_t)row * 64 + F.lane]; ld_row_bf16(F.HB + (size_t)row * D, F.lane, w[q]); } }
#pragma unroll
        for (int q = 0; q < 4; ++q) { const int row = row0 + q;
            if (row < M) { const float rs = 1.0f / sqrtf(wave_sum(st[q]) * (1.0f / D) + EPS);
#pragma unroll
                for (int j = 0; j < 8; ++j) { const int col = 8 * (64 * j + F.lane); float v[8]; { const u32x4 ww = w[q][j]; v[0] = pg8::hlo(ww.x); v[1] = pg8::hhi(ww.x); v[2] = pg8::hlo(ww.y); v[3] = pg8::hhi(ww.y); v[4] = pg8::hlo(ww.z); v[5] = pg8::hhi(ww.z); v[6] = pg8::hlo(ww.w); v[7] = pg8::hhi(ww.w); }
                    const f32x4 g0 = *(const GAS f32x4*)(F.gfin + col), g1 = *(const GAS f32x4*)(F.gfin + col + 4);
                    GAS f32x4* op = (GAS f32x4*)(F.out + (size_t)row * D + col);
                    op[0] = (f32x4){v[0] * rs * g0[0], v[1] * rs * g0[1], v[2] * rs * g0[2], v[3] * rs * g0[3]};
                    op[1] = (f32x4){v[4] * rs * g1[0], v[5] * rs * g1[1], v[6] * rs * g1[2], v[7] * rs * g1[3]}; } } }
    }
}

extern "C" void kernel_launch(void* const* d_in, const int* in_sizes, int n_in, void* d_out, int out_size, void* d_ws, size_t ws_size, hipStream_t stream) {
    static int grid = 0;
    if (grid == 0) {
        if (n_in != 17 || in_sizes[0] != M * D || out_size != M * D || ws_size < WS_END) { fprintf(stderr, "kernel_launch: unexpected shapes (n_in %d, in0 %d, out %d, ws %zu); nothing launched\n", n_in, n_in > 0 ? in_sizes[0] : -1, out_size, ws_size); grid = -1; return; }
        int dev = 0, cus = 0, per_cu = 0;
        if (hipGetDevice(&dev) != hipSuccess || hipDeviceGetAttribute(&cus, hipDeviceAttributeMultiprocessorCount, dev) != hipSuccess) { fprintf(stderr, "kernel_launch: device query failed\n"); grid = -1; return; }
        if (hipFuncSetAttribute((const void*)fwd_kernel, hipFuncAttributeMaxDynamicSharedMemorySize, LDS_BYTES) != hipSuccess) { fprintf(stderr, "kernel_launch: hipFuncSetAttribute failed\n"); grid = -1; return; }
        if (hipOccupancyMaxActiveBlocksPerMultiprocessor(&per_cu, (const void*)fwd_kernel, NWAVES * 64, LDS_BYTES) != hipSuccess || per_cu < 1)
            fprintf(stderr, "kernel_launch: note: occupancy query reports %d workgroups per CU\n", per_cu);
        (void)hipGetLastError();
        grid = cus;
    }
    if (grid < 0) return;
    if (hipMemsetAsync((char*)d_ws + WS_CTL, 0, CTL_ZERO_BYTES, stream) != hipSuccess) { fprintf(stderr, "kernel_launch: hipMemsetAsync failed\n"); return; }
    Args a{};
    for (int i = 0; i < 17; ++i) a.in[i] = (const float*)d_in[i];
    a.out = (float*)d_out; a.ws = (unsigned char*)d_ws;
    hipLaunchKernelGGL(fwd_kernel, dim3(grid), dim3(NWAVES * 64), LDS_BYTES, stream, a);
    const hipError_t le = hipPeekAtLastError();
    if (le != hipSuccess) fprintf(stderr, "kernel_launch: launch failed: %s\n", hipGetErrorName(le));
}
```

```cpp
#include <hip/hip_runtime.h>
#include <cstdio>

#define GAS __attribute__((address_space(1)))
#define LAS __attribute__((address_space(3)))
typedef unsigned short bf16_t;
typedef short bf16x8 __attribute__((ext_vector_type(8)));
typedef float f32x4 __attribute__((ext_vector_type(4)));
typedef float f32x2 __attribute__((ext_vector_type(2)));
typedef unsigned u32x4 __attribute__((ext_vector_type(4)));
typedef unsigned u32x2 __attribute__((ext_vector_type(2)));

constexpr int D = 4096, BATCH = 4, SEQ = 4096, M = BATCH * SEQ, NPROJ = 8192, PW = 2048, CW = 2048, FF = 16384, NMODW = 6 * D;
constexpr int PGD = 512;
constexpr bool I8_P5 = true;
constexpr int NQ7 = 64;
constexpr int NQ2 = 0;
constexpr bool PANEL_P0 = true;
constexpr bool R8_HID = true;
constexpr bool I8_P8 = true;
constexpr int PJ = 6144;
constexpr float EPS = 1e-6f;
constexpr int NWAVES = 8;

constexpr size_t MiB = 1u << 20;
constexpr size_t WS_CTL = 0, CTL_ZERO_BYTES = 128 * 1024;
constexpr size_t WS_HMAX = 64 * 1024;
constexpr size_t WS_MODPART = 1 * MiB;
constexpr size_t WS_MODFULL = 4 * MiB;
constexpr size_t WS_STATSP = 5 * MiB;
constexpr size_t WS_STATS1 = 7 * MiB;
constexpr size_t WS_STATS2 = 11 * MiB;
constexpr size_t WS_CS8 = 768 * MiB;
constexpr size_t WS_MIXT = 15 * MiB;
constexpr size_t WS_WIN = 32 * MiB;
constexpr size_t WS_WOUT = 96 * MiB;
constexpr size_t WS_W1 = 128 * MiB;
constexpr size_t WS_W2 = 256 * MiB;
constexpr size_t WS_HB = 384 * MiB;
constexpr size_t WS_HID = 512 * MiB;
constexpr size_t WS_PROJ = 512 * MiB;
constexpr size_t WS_MIXED = 768 * MiB;
constexpr size_t WS_POOLED = 896 * MiB;
constexpr size_t WS_END = 1024 * MiB;
constexpr size_t WS_W1Q = PANEL_P0 ? 960 * MiB : 32 * MiB;
constexpr size_t WS_WOUTQ = PANEL_P0 ? 704 * MiB : 448 * MiB;
constexpr size_t WS_H2Q = 384 * MiB;
constexpr size_t WS_MIXQ = 896 * MiB;
constexpr size_t WS_WINQ = 768 * MiB;
constexpr size_t WS_HIDQ = 128 * MiB;
constexpr size_t WS_SA8 = 20 * MiB + 6 * 65536, WS_SB2 = 20 * MiB + 7 * 65536, WS_CS2 = 20 * MiB + 8 * 65536;
constexpr size_t WS_SA1 = 20 * MiB + 4 * 65536, WS_SBIN = 20 * MiB + 5 * 65536;
constexpr size_t WS_SBOUT = 20 * MiB, WS_SB1 = 20 * MiB + 65536, WS_SA5 = 20 * MiB + 2 * 65536, WS_SA7 = 20 * MiB + 3 * 65536;

constexpr int RING_BYTES = 131072;
constexpr int MISC_OFF = RING_BYTES;
constexpr int LDS_BYTES = 147456;

namespace pg8 {
constexpr int BM = 256, BK = 64, HALF = 128, HTB = HALF * BK * 2, STAGE_BYTES = 8 * HTB, NXCD = 8, WGM = 8;
__host__ __device__ __forceinline__ int lds_byte(int r, int c) { const int st = (r >> 4) * 2 + (c >> 5), rr = r & 15, cc = c & 31, ob = rr * 64 + cc * 2; return st * 1024 + (ob ^ (((ob >> 9) & 1) << 5)); }
__host__ __device__ __forceinline__ void stage_rc(int b, int& R, int& C) { const int st = b / 1024, sb = b % 1024, swz = sb ^ (((sb >> 9) & 1) << 5); R = (st >> 1) * 16 + swz / 64; C = (st & 1) * 32 + (swz % 64) / 2; }
__host__ __device__ __forceinline__ int perm32(int rho) { const int n = rho >> 4, i = rho & 15; return 8 * (i >> 2) + 4 * n + (i & 3); }

typedef int i32x4 __attribute__((ext_vector_type(4)));
__device__ __forceinline__ f32x4 mma16(bf16x8 b, bf16x8 a, f32x4 c) { return __builtin_amdgcn_mfma_f32_16x16x32_bf16(b, a, c, 0, 0, 0); }
__device__ __forceinline__ i32x4 mma16(bf16x8 b, bf16x8 a, i32x4 c) { return __builtin_amdgcn_mfma_i32_16x16x64_i8(__builtin_bit_cast(i32x4, b), __builtin_bit_cast(i32x4, a), c, 0, 0, 0); }
typedef _Float16 f16x2 __attribute__((ext_vector_type(2)));
__device__ __forceinline__ unsigned cvt_pk_h(float lo, float hi) { const f16x2 v = {(_Float16)lo, (_Float16)hi}; return __builtin_bit_cast(unsigned, v); }
__device__ __forceinline__ float hlo(unsigned w) { return (float)__builtin_bit_cast(f16x2, w)[0]; }
__device__ __forceinline__ float hhi(unsigned w) { return (float)__builtin_bit_cast(f16x2, w)[1]; }
struct Unit { int pm, pn; };
struct Gemm { const bf16_t* A; const bf16_t* Bt; int K, lda, ldb; };

struct StaticOrder {
    int nM, nN, nwg, G, c, acol_shift, acol_mul;
    __device__ void init(int M_, int N_, int G_, int c_, int sh = 0, int mul = 0) { nM = M_ / BM; nN = N_ / BM; nwg = nM * nN; G = G_; c = c_; acol_shift = sh; acol_mul = mul; }
    __device__ bool next(int i, Unit& u) const {
        const long L = (long)i * G + c; if (L >= nwg) return false;
        int wgid = (int)L; { const int q = nwg / NXCD, r = nwg % NXCD, xcd = wgid % NXCD, off = wgid / NXCD; wgid = (xcd < r ? xcd * (q + 1) : r * (q + 1) + (xcd - r) * q) + off; }
        const int nig = WGM * nN, gid = wgid / nig, fm = gid * WGM, gsz = (nM - fm) < WGM ? (nM - fm) : WGM;
        u.pm = fm + ((wgid % nig) % gsz); u.pn = (wgid % nig) / gsz; return true;
    }
    __device__ __forceinline__ int a_coloff(const Unit& u) const { return (u.pn >> acol_shift) * acol_mul; }
};

__device__ __forceinline__ unsigned pack4_rne(float a, float b, float c, float d, float inv) {
    constexpr float MAGIC = 12582912.0f;
    const unsigned ua = __builtin_bit_cast(unsigned, __builtin_fmaf(a, inv, MAGIC)), ub = __builtin_bit_cast(unsigned, __builtin_fmaf(b, inv, MAGIC));
    const unsigned uc = __builtin_bit_cast(unsigned, __builtin_fmaf(c, inv, MAGIC)), ud = __builtin_bit_cast(unsigned, __builtin_fmaf(d, inv, MAGIC));
    return __builtin_amdgcn_perm(__builtin_amdgcn_perm(ud, uc, 0x0c0c0400u), __builtin_amdgcn_perm(ub, ua, 0x0c0c0400u), 0x05040100u);
}
__device__ __forceinline__ unsigned cvt_pk_bf16(float lo, float hi) { unsigned r; asm volatile("v_cvt_pk_bf16_f32 %0, %1, %2" : "=v"(r) : "v"(lo), "v"(hi)); return r; }

template <int ACT  > struct EpiBf16 {
    static constexpr bool PERM = true; typedef f32x4 acc_t;
    bf16_t* O; int ldc; unsigned* hmax;
    __device__ __forceinline__ void operator()(const f32x4 (&acc)[2][2][4][2], const Unit& u, int wr, int wc, int fr, int fq) const {
        const int row0 = u.pm * BM + wr * 64 + fr, col0 = u.pn * BM + wc * 32 + 8 * fq;
#pragma unroll
        for (int ai = 0; ai < 2; ++ai)
#pragma unroll
            for (int m = 0; m < 4; ++m) { const int row = row0 + ai * HALF + m * 16; bf16_t* rowp = O + (size_t)row * ldc + col0; float mxv = 0.f;
#pragma unroll
                for (int bj = 0; bj < 2; ++bj) { f32x4 v0 = acc[ai][bj][m][0], v1 = acc[ai][bj][m][1];
                    if (ACT == 1) {
#pragma unroll
                        for (int j = 0; j < 4; ++j) { const float a = fmaxf(v0[j], 0.f), b = fmaxf(v1[j], 0.f); v0[j] = a * a; v1[j] = b * b; mxv = fmaxf(mxv, fmaxf(v0[j], v1[j])); } }
                    u32x4 w; w.x = cvt_pk_bf16(v0[0], v0[1]); w.y = cvt_pk_bf16(v0[2], v0[3]); w.z = cvt_pk_bf16(v1[0], v1[1]); w.w = cvt_pk_bf16(v1[2], v1[3]);
                    *(u32x4*)(rowp + bj * HALF) = w; }
                if (ACT == 1 && hmax) { mxv = fmaxf(mxv, __shfl_xor(mxv, 16)); mxv = fmaxf(mxv, __shfl_xor(mxv, 32));
                    if (fq == 0) __hip_atomic_fetch_max(hmax + row, __builtin_bit_cast(unsigned, mxv), __ATOMIC_RELAXED, __HIP_MEMORY_SCOPE_AGENT); } }
    }
};
struct EpiProj {
    static constexpr bool PERM = true; typedef f32x4 acc_t;
    bf16_t* O; int pn0;
    __device__ __forceinline__ void operator()(const f32x4 (&acc)[2][2][4][2], const Unit& u_, int wr, int wc, int fr, int fq) const {
        Unit u = u_; u.pn += pn0;
        const int row0 = u.pm * BM + wr * 64 + fr;
        if (u.pn < 16) {
            const int col0 = u.pn * BM + wc * 32 + 8 * fq;
#pragma unroll
            for (int ai = 0; ai < 2; ++ai)
#pragma unroll
                for (int m = 0; m < 4; ++m) { bf16_t* rowp = O + (size_t)(row0 + ai * HALF + m * 16) * PJ + col0;
#pragma unroll
                    for (int bj = 0; bj < 2; ++bj) { const f32x4 v0 = acc[ai][bj][m][0], v1 = acc[ai][bj][m][1];
                        u32x4 w; w.x = cvt_pk_bf16(v0[0], v0[1]); w.y = cvt_pk_bf16(v0[2], v0[3]); w.z = cvt_pk_bf16(v1[0], v1[1]); w.w = cvt_pk_bf16(v1[2], v1[3]);
                        *(GAS u32x4*)(rowp + bj * HALF) = w; } }
        } else {
            const int col0 = 2 * PW + (u.pn - 16) * HALF + wc * 32 + 8 * fq;
#pragma unroll
            for (int ai = 0; ai < 2; ++ai)
#pragma unroll
                for (int m = 0; m < 4; ++m) { const f32x4 v0 = acc[ai][0][m][0] * acc[ai][1][m][0], v1 = acc[ai][0][m][1] * acc[ai][1][m][1];
                    u32x4 w; w.x = cvt_pk_bf16(v0[0], v0[1]); w.y = cvt_pk_bf16(v0[2], v0[3]); w.z = cvt_pk_bf16(v1[0], v1[1]); w.w = cvt_pk_bf16(v1[2], v1[3]);
                    *(GAS u32x4*)(O + (size_t)(row0 + ai * HALF + m * 16) * PJ + col0) = w; }
        }
    }
};
struct EpiProjI8 {
    static constexpr bool PERM = true; typedef i32x4 acc_t;
    bf16_t* O; const float* sa; const float* sb;
    __device__ __forceinline__ void operator()(const i32x4 (&acc)[2][2][4][2], const Unit& u, int wr, int wc, int fr, int fq) const {
        const int row0 = u.pm * BM + wr * 64 + fr, col0 = u.pn * BM + wc * 32 + 8 * fq;
        f32x4 sbv[2][2];
#pragma unroll
        for (int bj = 0; bj < 2; ++bj)
#pragma unroll
            for (int n = 0; n < 2; ++n) sbv[bj][n] = *(const GAS f32x4*)(sb + col0 + bj * HALF + 4 * n);
#pragma unroll
        for (int ai = 0; ai < 2; ++ai)
#pragma unroll
            for (int m = 0; m < 4; ++m) { const int row = row0 + ai * HALF + m * 16; const float sar = *(const GAS float*)(sa + row); bf16_t* rowp = O + (size_t)row * PJ + col0;
#pragma unroll
                for (int bj = 0; bj < 2; ++bj) { f32x4 v0, v1;
#pragma unroll
                    for (int j = 0; j < 4; ++j) { v0[j] = (float)acc[ai][bj][m][0][j] * sar * sbv[bj][0][j]; v1[j] = (float)acc[ai][bj][m][1][j] * sar * sbv[bj][1][j]; }
                    u32x4 w; w.x = cvt_pk_bf16(v0[0], v0[1]); w.y = cvt_pk_bf16(v0[2], v0[3]); w.z = cvt_pk_bf16(v1[0], v1[1]); w.w = cvt_pk_bf16(v1[2], v1[3]);
                    *(GAS u32x4*)(rowp + bj * HALF) = w; } }
    }
};
struct EpiPoolMix {
    static constexpr bool PERM = true; typedef f32x4 acc_t;
    bf16_t* O; int ldc; const float* scale; float* stats;
    __device__ __forceinline__ void operator()(const f32x4 (&acc)[2][2][4][2], const Unit& u, int wr, int wc, int fr, int fq) const {
        const int row0 = u.pm * BM + wr * 64 + fr, col0 = u.pn * BM + wc * 32 + 8 * fq;
        f32x4 sv[2][2];
#pragma unroll
        for (int bj = 0; bj < 2; ++bj)
#pragma unroll
            for (int n = 0; n < 2; ++n) sv[bj][n] = *(const GAS f32x4*)(scale + col0 + bj * HALF + 4 * n);
#pragma unroll
        for (int ai = 0; ai < 2; ++ai)
#pragma unroll
            for (int m = 0; m < 4; ++m) { const int row = row0 + ai * HALF + m * 16; bf16_t* rowp = O + (size_t)row * ldc + col0; float ss = 0.f;
#pragma unroll
                for (int bj = 0; bj < 2; ++bj) { const f32x4 v0 = acc[ai][bj][m][0] * sv[bj][0], v1 = acc[ai][bj][m][1] * sv[bj][1];
                    ss += (v0[0] * v0[0] + v0[1] * v0[1]) + (v0[2] * v0[2] + v0[3] * v0[3]) + (v1[0] * v1[0] + v1[1] * v1[1]) + (v1[2] * v1[2] + v1[3] * v1[3]);
                    u32x4 w; w.x = cvt_pk_bf16(v0[0], v0[1]); w.y = cvt_pk_bf16(v0[2], v0[3]); w.z = cvt_pk_bf16(v1[0], v1[1]); w.w = cvt_pk_bf16(v1[2], v1[3]);
                    *(u32x4*)(rowp + bj * HALF) = w; }
                ss += __shfl_xor(ss, 16); ss += __shfl_xor(ss, 32);
                if (fq == 0) stats[(size_t)row * 32 + u.pn * 4 + wc] = ss; }
    }
};
template <bool BASE_BF16> struct EpiResid {
    static constexpr bool PERM = true; typedef f32x4 acc_t;
    const void* base; bf16_t* out; const float* gate  ; float* stats;
    __device__ __forceinline__ void operator()(const f32x4 (&acc)[2][2][4][2], const Unit& u, int wr, int wc, int fr, int fq) const {
        const int row0 = u.pm * BM + wr * 64 + fr, col0 = u.pn * BM + wc * 32 + 8 * fq;
        const float* gp = gate + (size_t)(u.pm >> 4) * NMODW + col0;
        f32x4 gv[2][2];
#pragma unroll
        for (int bj = 0; bj < 2; ++bj)
#pragma unroll
            for (int n = 0; n < 2; ++n) gv[bj][n] = *(const GAS f32x4*)(gp + bj * HALF + 4 * n);
#pragma unroll
        for (int ai = 0; ai < 2; ++ai)
#pragma unroll
            for (int m = 0; m < 4; ++m) { const int row = row0 + ai * HALF + m * 16; const size_t off = (size_t)row * D + col0; float ss = 0.f;
#pragma unroll
                for (int bj = 0; bj < 2; ++bj) { f32x4 b0, b1;
                    if (BASE_BF16) { const u32x4 w = *(const GAS u32x4*)((const bf16_t*)base + off + bj * HALF);
                        b0 = (f32x4){hlo(w.x), hhi(w.x), hlo(w.y), hhi(w.y)};
                        b1 = (f32x4){hlo(w.z), hhi(w.z), hlo(w.w), hhi(w.w)}; }
                    else { b0 = *(const GAS f32x4*)((const float*)base + off + bj * HALF); b1 = *(const GAS f32x4*)((const float*)base + off + bj * HALF + 4); }
                    const f32x4 o0 = b0 + gv[bj][0] * acc[ai][bj][m][0], o1 = b1 + gv[bj][1] * acc[ai][bj][m][1];
                    ss += (o0[0] * o0[0] + o0[1] * o0[1]) + (o0[2] * o0[2] + o0[3] * o0[3]) + (o1[0] * o1[0] + o1[1] * o1[1]) + (o1[2] * o1[2] + o1[3] * o1[3]);
                    u32x4 w; w.x = cvt_pk_h(o0[0], o0[1]); w.y = cvt_pk_h(o0[2], o0[3]); w.z = cvt_pk_h(o1[0], o1[1]); w.w = cvt_pk_h(o1[2], o1[3]);
                    *(GAS u32x4*)(out + off + bj * HALF) = w; }
                ss += __shfl_xor(ss, 16); ss += __shfl_xor(ss, 32);
                if (fq == 0) stats[(size_t)row * 64 + u.pn * 4 + wc] = ss;
                asm volatile("" ::: "memory"); }
    }
};

struct EpiActI8 {
    static constexpr bool PERM = true; typedef i32x4 acc_t;
    bf16_t* O; int ldc; const float* sa; const float* sb; unsigned* hmax;
    __device__ __forceinline__ void operator()(const i32x4 (&acc)[2][2][4][2], const Unit& u, int wr, int wc, int fr, int fq) const {
        const int row0 = u.pm * BM + wr * 64 + fr, col0 = u.pn * BM + wc * 32 + 8 * fq;
        f32x4 sbv[2][2];
#pragma unroll
        for (int bj = 0; bj < 2; ++bj)
#pragma unroll
            for (int n = 0; n < 2; ++n) sbv[bj][n] = *(const GAS f32x4*)(sb + col0 + bj * HALF + 4 * n);
#pragma unroll
        for (int ai = 0; ai < 2; ++ai)
#pragma unroll
            for (int m = 0; m < 4; ++m) { const int row = row0 + ai * HALF + m * 16; const float sar = *(const GAS float*)(sa + row); bf16_t* rowp = O + (size_t)row * ldc + col0; float mxv = 0.f;
#pragma unroll
                for (int bj = 0; bj < 2; ++bj) { f32x4 v0, v1;
#pragma unroll
                    for (int j = 0; j < 4; ++j) { const float a = fmaxf((float)acc[ai][bj][m][0][j] * sar * sbv[bj][0][j], 0.f), b = fmaxf((float)acc[ai][bj][m][1][j] * sar * sbv[bj][1][j], 0.f); v0[j] = a * a; v1[j] = b * b; mxv = fmaxf(mxv, fmaxf(v0[j], v1[j])); }
                    u32x4 w; w.x = cvt_pk_bf16(v0[0], v0[1]); w.y = cvt_pk_bf16(v0[2], v0[3]); w.z = cvt_pk_bf16(v1[0], v1[1]); w.w = cvt_pk_bf16(v1[2], v1[3]);
                    *(GAS u32x4*)(rowp + bj * HALF) = w; }
                if (hmax) { mxv = fmaxf(mxv, __shfl_xor(mxv, 16)); mxv = fmaxf(mxv, __shfl_xor(mxv, 32));
                    if (fq == 0) __hip_atomic_fetch_max(hmax + row, __builtin_bit_cast(unsigned, mxv), __ATOMIC_RELAXED, __HIP_MEMORY_SCOPE_AGENT); } }
    }
};
struct EpiActR8 {
    static constexpr int PERM = 2; typedef i32x4 acc_t;
    unsigned char* O; int ldc; const float* sa; const float* sb; float* cs;
    __device__ __forceinline__ void operator()(const i32x4 (&acc)[2][2][4][2], const Unit& u, int wr, int wc, int fr, int fq) const {
        const int row0 = u.pm * BM + wr * 64 + fr, col0 = u.pn * BM + wc * 64 + 16 * fq;
        f32x4 sbv[2][2];
#pragma unroll
        for (int bj = 0; bj < 2; ++bj)
#pragma unroll
            for (int n = 0; n < 2; ++n) sbv[bj][n] = *(const GAS f32x4*)(sb + col0 + 8 * bj + 4 * n);
#pragma unroll
        for (int ai = 0; ai < 2; ++ai)
#pragma unroll
            for (int m = 0; m < 4; ++m) { const int row = row0 + ai * HALF + m * 16; float r[16]; float mx = 0.f;
#pragma unroll
                for (int bj = 0; bj < 2; ++bj)
#pragma unroll
                    for (int n = 0; n < 2; ++n)
#pragma unroll
                        for (int j = 0; j < 4; ++j) { const float v = fmaxf((float)acc[ai][bj][m][n][j], 0.f) * sbv[bj][n][j]; r[8 * bj + 4 * n + j] = v; mx = fmaxf(mx, v); }
                mx = fmaxf(mx, __shfl_xor(mx, 16)); mx = fmaxf(mx, __shfl_xor(mx, 32));
                const float inv = mx > 0.f ? 255.0f / mx : 0.f; unsigned o[4];
#pragma unroll
                for (int d = 0; d < 4; ++d) o[d] = pack4_rne(r[4 * d], r[4 * d + 1], r[4 * d + 2], r[4 * d + 3], inv);
                *(GAS u32x4*)(O + (size_t)row * ldc + col0) = (u32x4){o[0], o[1], o[2], o[3]};
                if (fq == 0) cs[(size_t)row * (ldc >> 6) + u.pn * 4 + wc] = mx * *(const GAS float*)(sa + row) * (1.0f / 255.0f);
                asm volatile("" ::: "memory"); }
    }
};
struct EpiResidI8 {
    static constexpr bool PERM = true; typedef i32x4 acc_t;
    const float* base; bf16_t* out; const float* gate; float* stats; const float* sa; const float* sb;
    __device__ __forceinline__ void operator()(const i32x4 (&acc)[2][2][4][2], const Unit& u, int wr, int wc, int fr, int fq) const {
        const int row0 = u.pm * BM + wr * 64 + fr, col0 = u.pn * BM + wc * 32 + 8 * fq;
        const float* gp = gate + (size_t)(u.pm >> 4) * NMODW + col0;
        f32x4 gv[2][2];
#pragma unroll
        for (int bj = 0; bj < 2; ++bj)
#pragma unroll
            for (int n = 0; n < 2; ++n) gv[bj][n] = *(const GAS f32x4*)(gp + bj * HALF + 4 * n) * *(const GAS f32x4*)(sb + col0 + bj * HALF + 4 * n);
#pragma unroll
        for (int ai = 0; ai < 2; ++ai)
#pragma unroll
            for (int m = 0; m < 4; ++m) { const int row = row0 + ai * HALF + m * 16; const size_t off = (size_t)row * D + col0; float ss = 0.f; const float sar = *(const GAS float*)(sa + row);
#pragma unroll
                for (int bj = 0; bj < 2; ++bj) { const f32x4 b0 = *(const GAS f32x4*)(base + off + bj * HALF), b1 = *(const GAS f32x4*)(base + off + bj * HALF + 4); f32x4 o0, o1;
#pragma unroll
                    for (int j = 0; j < 4; ++j) { o0[j] = b0[j] + gv[bj][0][j] * ((float)acc[ai][bj][m][0][j] * sar); o1[j] = b1[j] + gv[bj][1][j] * ((float)acc[ai][bj][m][1][j] * sar); }
                    ss += (o0[0] * o0[0] + o0[1] * o0[1]) + (o0[2] * o0[2] + o0[3] * o0[3]) + (o1[0] * o1[0] + o1[1] * o1[1]) + (o1[2] * o1[2] + o1[3] * o1[3]);
                    u32x4 w; w.x = cvt_pk_h(o0[0], o0[1]); w.y = cvt_pk_h(o0[2], o0[3]); w.z = cvt_pk_h(o1[0], o1[1]); w.w = cvt_pk_h(o1[2], o1[3]);
                    *(GAS u32x4*)(out + off + bj * HALF) = w; }
                ss += __shfl_xor(ss, 16); ss += __shfl_xor(ss, 32);
                if (fq == 0) stats[(size_t)row * 64 + u.pn * 4 + wc] = ss;
                asm volatile("" ::: "memory"); }
    }
};

struct EpiResidQ8 {
    static constexpr bool PERM = true, H16 = false; typedef i32x4 acc_t;
    const bf16_t* base; bf16_t* out; const float* gate; float* stats; const float* sa; const float* sb; const int* csum;
    __device__ __forceinline__ void operator()(const i32x4 (&acc)[2][2][4][2], const Unit& u, int wr, int wc, int fr, int fq) const {
        const int row0 = u.pm * BM + wr * 64 + fr, col0 = u.pn * BM + wc * 32 + 8 * fq;
        const float* gp = gate + (size_t)(u.pm >> 4) * NMODW + col0;
        f32x4 gv[2][2]; i32x4 cs[2][2];
#pragma unroll
        for (int bj = 0; bj < 2; ++bj)
#pragma unroll
            for (int n = 0; n < 2; ++n) { gv[bj][n] = *(const GAS f32x4*)(gp + bj * HALF + 4 * n) * *(const GAS f32x4*)(sb + col0 + bj * HALF + 4 * n);
                cs[bj][n] = *(const GAS i32x4*)(csum + col0 + bj * HALF + 4 * n) * 128; }
#pragma unroll
        for (int ai = 0; ai < 2; ++ai)
#pragma unroll
            for (int m = 0; m < 4; ++m) { const int row = row0 + ai * HALF + m * 16; const size_t off = (size_t)row * D + col0; float ss = 0.f; const float sar = *(const GAS float*)(sa + row);
#pragma unroll
                for (int bj = 0; bj < 2; ++bj) { const u32x4 w = *(const GAS u32x4*)(base + off + bj * HALF);
                    const f32x4 b0 = (f32x4){hlo(w.x), hhi(w.x), hlo(w.y), hhi(w.y)}, b1 = (f32x4){hlo(w.z), hhi(w.z), hlo(w.w), hhi(w.w)};
                    const i32x4 a0 = acc[ai][bj][m][0] + cs[bj][0], a1 = acc[ai][bj][m][1] + cs[bj][1]; f32x4 o0, o1;
#pragma unroll
                    for (int j = 0; j < 4; ++j) { o0[j] = b0[j] + gv[bj][0][j] * ((float)a0[j] * sar); o1[j] = b1[j] + gv[bj][1][j] * ((float)a1[j] * sar); }
                    ss += (o0[0] * o0[0] + o0[1] * o0[1]) + (o0[2] * o0[2] + o0[3] * o0[3]) + (o1[0] * o1[0] + o1[1] * o1[1]) + (o1[2] * o1[2] + o1[3] * o1[3]);
                    u32x4 wq; wq.x = cvt_pk_h(o0[0], o0[1]); wq.y = cvt_pk_h(o0[2], o0[3]); wq.z = cvt_pk_h(o1[0], o1[1]); wq.w = cvt_pk_h(o1[2], o1[3]);
                    *(GAS u32x4*)(out + off + bj * HALF) = wq; }
                ss += __shfl_xor(ss, 16); ss += __shfl_xor(ss, 32);
                if (fq == 0) stats[(size_t)row * 64 + u.pn * 4 + wc] = ss;
                asm volatile("" ::: "memory"); }
    }
};

template <class Epi, class Sched, bool ALIGN_EPI = true, bool SP2 = true>
__device__ __forceinline__ void gemm_phase(LAS unsigned char* lds, const Gemm g, const Sched& S, const Epi& E) {
    int tid_ = threadIdx.x; asm volatile("" : "+v"(tid_));
    const int tid = tid_, wid = __builtin_amdgcn_readfirstlane(tid >> 6), lane = tid & 63, wr = wid >> 2, wc = wid & 3, fr = lane & 15, fq = lane >> 4;
    const int K = g.K, nt = K / BK;
    unsigned voffA[2], voffB[2];
#pragma unroll
    for (int i = 0; i < 2; ++i) { int R, C; stage_rc(tid * 16 + i * 8192, R, C); const int Rb = (Epi::PERM == 2) ? (64 * (R >> 5) + 16 * ((R >> 2) & 3) + 4 * ((R >> 4) & 1) + (R & 3)) : Epi::PERM ? ((R & ~31) + perm32(R & 31)) : R;
        voffA[i] = (unsigned)(R * g.lda + C) * 2u; voffB[i] = (unsigned)(Rb * g.ldb + C) * 2u; }
    const size_t kstep = (size_t)(BK * 2);
    const size_t hstepA = (size_t)HALF * g.lda * 2, hstepB = (size_t)((Epi::PERM == 2) ? 8 : HALF) * g.ldb * 2;
    const size_t tstepA = 2 * hstepA, tstepB = (size_t)BM * g.ldb * 2;
    const unsigned ldsw = (unsigned)wid * 1024u;
    const int aoff = lds_byte(wr * 64 + fr, fq * 8), boff = lds_byte(wc * 32 + fr, fq * 8);
#define PG8_SA(b, h) (((b) * 2 + (h)) * HTB)
#define PG8_SB(b, h) ((4 + (b) * 2 + (h)) * HTB)
#define PG8_STAGE(bufoff, gbase, voff) do { _Pragma("unroll") for (int _i = 0; _i < 2; ++_i) \
        __builtin_amdgcn_global_load_lds((const unsigned*)((const char*)(gbase) + (voff)[_i]), (LAS unsigned*)(lds + (bufoff) + ldsw + _i * 8192), 16, 0, 0); } while (0)
#define PG8_LDA(dst, b, h) do { _Pragma("unroll") for (int m = 0; m < 4; ++m) _Pragma("unroll") for (int k = 0; k < 2; ++k) dst[m][k] = *(const LAS bf16x8*)(lds + PG8_SA(b, h) + aoff + m * 2048 + k * 1024); } while (0)
#define PG8_LDB(dst, b, h) do { _Pragma("unroll") for (int n = 0; n < 2; ++n) _Pragma("unroll") for (int k = 0; k < 2; ++k) dst[n][k] = *(const LAS bf16x8*)(lds + PG8_SB(b, h) + boff + n * 2048 + k * 1024); } while (0)
#define PG8_MMA(ai, bj, At, Bt) do { __builtin_amdgcn_s_setprio(1); _Pragma("unroll") for (int m = 0; m < 4; ++m) _Pragma("unroll") for (int n = 0; n < 2; ++n) _Pragma("unroll") for (int k = 0; k < 2; ++k) \
        acc[ai][bj][m][n] = mma16(Bt[n][k], At[m][k], acc[ai][bj][m][n]); __builtin_amdgcn_s_setprio(0); } while (0)
#define PG8_WAIT_V(n) asm volatile("s_waitcnt vmcnt(" #n ")" ::: "memory")
#define PG8_WAIT_L(n) asm volatile("s_waitcnt lgkmcnt(" #n ")" ::: "memory")
#define PG8_BAR __builtin_amdgcn_s_barrier()
#define PG8_SCHED __builtin_amdgcn_sched_barrier(0)
    Unit cur, nxt; int ui = 0;
    if (!S.next(0, cur)) return;
    typedef typename Epi::acc_t acc_t;
    acc_t acc[2][2][4][2];
#pragma unroll
    for (int a = 0; a < 2; ++a)
#pragma unroll
        for (int b = 0; b < 2; ++b)
#pragma unroll
            for (int m = 0; m < 4; ++m)
#pragma unroll
                for (int n = 0; n < 2; ++n) acc[a][b][m][n] = (acc_t){0, 0, 0, 0};
    bf16x8 At[4][2], B0[2][2], B1[2][2];
    const char* cA = (const char*)g.A + (size_t)cur.pm * tstepA + (size_t)S.a_coloff(cur) * 2; const char* cB = (const char*)g.Bt + (size_t)cur.pn * tstepB;
    if constexpr (SP2) {
        PG8_STAGE(PG8_SB(0, 0), cB, voffB); PG8_STAGE(PG8_SB(0, 1), cB + hstepB, voffB); PG8_STAGE(PG8_SA(0, 0), cA, voffA); PG8_STAGE(PG8_SA(0, 1), cA + hstepA, voffA);
        if (wr == 1) PG8_BAR;
        PG8_WAIT_V(2); PG8_BAR;
        PG8_STAGE(PG8_SB(1, 0), cB + kstep, voffB); PG8_STAGE(PG8_SA(1, 0), cA + kstep, voffA); PG8_STAGE(PG8_SB(1, 1), cB + hstepB + kstep, voffB);
        PG8_WAIT_V(6); PG8_BAR;
    } else {
        PG8_STAGE(PG8_SB(0, 0), cB, voffB); PG8_STAGE(PG8_SA(0, 0), cA, voffA); PG8_STAGE(PG8_SB(0, 1), cB + hstepB, voffB); PG8_STAGE(PG8_SA(0, 1), cA + hstepA, voffA);
        if (wr == 1) PG8_BAR;
        PG8_WAIT_V(4); PG8_BAR;
        PG8_STAGE(PG8_SB(1, 0), cB + kstep, voffB); PG8_STAGE(PG8_SA(1, 0), cA + kstep, voffA); PG8_STAGE(PG8_SB(1, 1), cB + hstepB + kstep, voffB);
        PG8_WAIT_V(6); PG8_BAR;
    }
    for (;;) {
        const bool has_next = S.next(ui + 1, nxt);
        const char* nA = has_next ? (const char*)g.A + (size_t)nxt.pm * tstepA + (size_t)S.a_coloff(nxt) * 2 : cA; const char* nB = has_next ? (const char*)g.Bt + (size_t)nxt.pn * tstepB : cB;
        for (int t = 0; t < nt; t += 2) {
            const bool last = (t == nt - 2);
            const char* a1 = cA + (size_t)(t + 1) * kstep;
            const char* a2 = last ? nA : cA + (size_t)(t + 2) * kstep; const char* b2 = last ? nB : cB + (size_t)(t + 2) * kstep;
            const char* a3 = a2 + kstep; const char* b3 = b2 + kstep;
            if constexpr (SP2) {
            PG8_LDB(B0, 0, 0); PG8_LDB(B1, 0, 1); PG8_SCHED; PG8_LDA(At, 0, 0); PG8_STAGE(PG8_SA(1, 1), a1 + hstepA, voffA);
            PG8_WAIT_V(8); PG8_WAIT_L(0); PG8_BAR; PG8_MMA(0, 0, At, B0); PG8_MMA(0, 1, At, B1); PG8_BAR; PG8_SCHED;
            PG8_LDA(At, 0, 1); PG8_STAGE(PG8_SB(0, 0), b2, voffB); PG8_STAGE(PG8_SB(0, 1), b2 + hstepB, voffB); PG8_STAGE(PG8_SA(0, 0), a2, voffA);
            PG8_WAIT_V(8); PG8_WAIT_L(0); PG8_BAR; PG8_MMA(1, 0, At, B0); PG8_MMA(1, 1, At, B1); PG8_BAR; PG8_SCHED;
            PG8_LDB(B0, 1, 0); PG8_LDB(B1, 1, 1); PG8_SCHED; PG8_LDA(At, 1, 0); PG8_STAGE(PG8_SA(0, 1), a2 + hstepA, voffA);
            PG8_WAIT_V(8); PG8_WAIT_L(0); PG8_BAR; PG8_MMA(0, 0, At, B0); PG8_MMA(0, 1, At, B1); PG8_BAR; PG8_SCHED;
            PG8_LDA(At, 1, 1); PG8_STAGE(PG8_SB(1, 0), b3, voffB); PG8_STAGE(PG8_SB(1, 1), b3 + hstepB, voffB); PG8_STAGE(PG8_SA(1, 0), a3, voffA);
            PG8_WAIT_V(8); PG8_WAIT_L(0); PG8_BAR; PG8_MMA(1, 0, At, B0); PG8_MMA(1, 1, At, B1); PG8_BAR; PG8_SCHED;
            } else {
            PG8_LDB(B0, 0, 0); PG8_SCHED; PG8_LDA(At, 0, 0); PG8_STAGE(PG8_SA(1, 1), a1 + hstepA, voffA);
            PG8_WAIT_L(8); PG8_BAR; PG8_WAIT_L(0); PG8_MMA(0, 0, At, B0); PG8_BAR; PG8_SCHED;
            PG8_LDB(B1, 0, 1); PG8_STAGE(PG8_SB(0, 0), b2, voffB);
            PG8_BAR; PG8_WAIT_L(0); PG8_MMA(0, 1, At, B1); PG8_BAR;
            PG8_LDA(At, 0, 1); PG8_STAGE(PG8_SA(0, 0), a2, voffA);
            PG8_BAR; PG8_WAIT_L(0); PG8_MMA(1, 0, At, B0); PG8_BAR; PG8_SCHED;
            PG8_STAGE(PG8_SB(0, 1), b2 + hstepB, voffB);
            PG8_WAIT_V(6); PG8_BAR; PG8_MMA(1, 1, At, B1); PG8_BAR;
            PG8_LDB(B0, 1, 0); PG8_SCHED; PG8_LDA(At, 1, 0); PG8_STAGE(PG8_SA(0, 1), a2 + hstepA, voffA);
            PG8_WAIT_L(8); PG8_BAR; PG8_WAIT_L(0); PG8_MMA(0, 0, At, B0); PG8_BAR; PG8_SCHED;
            PG8_LDB(B1, 1, 1); PG8_STAGE(PG8_SB(1, 0), b3, voffB);
            PG8_BAR; PG8_WAIT_L(0); PG8_MMA(0, 1, At, B1); PG8_BAR;
            PG8_LDA(At, 1, 1); PG8_STAGE(PG8_SA(1, 0), a3, voffA);
            PG8_BAR; PG8_WAIT_L(0); PG8_MMA(1, 0, At, B0); PG8_BAR; PG8_SCHED;
            PG8_STAGE(PG8_SB(1, 1), b3 + hstepB, voffB);
            PG8_WAIT_V(6); PG8_BAR; PG8_MMA(1, 1, At, B1); PG8_BAR;
            }
        }
        if constexpr (ALIGN_EPI) { if (wr == 0) PG8_BAR; }
        E(acc, cur, wr, wc, fr, fq);
        if (!has_next) break;
#pragma unroll
        for (int a = 0; a < 2; ++a)
#pragma unroll
            for (int b = 0; b < 2; ++b)
#pragma unroll
                for (int m = 0; m < 4; ++m)
#pragma unroll
                    for (int n = 0; n < 2; ++n) acc[a][b][m][n] = (acc_t){0, 0, 0, 0};
        cur = nxt; cA = nA; cB = nB; ++ui;
        if constexpr (ALIGN_EPI) { if (wr == 1) PG8_BAR; }
    }
    PG8_WAIT_V(0);
    if constexpr (!ALIGN_EPI) { if (wr == 0) PG8_BAR; }
    PG8_BAR;
#undef PG8_SA
#undef PG8_SB
#undef PG8_STAGE
#undef PG8_LDA
#undef PG8_LDB
#undef PG8_MMA
#undef PG8_WAIT_V
#undef PG8_WAIT_L
#undef PG8_BAR
#undef PG8_SCHED
}
}

#define LDS_WAIT() asm volatile("s_waitcnt lgkmcnt(0)" ::: "memory")
__device__ __forceinline__ unsigned f2bf(float f) { unsigned u = __builtin_bit_cast(unsigned, f); return (u + 0x7fffu + ((u >> 16) & 1u)) >> 16; }
__device__ __forceinline__ unsigned pk2(float lo, float hi) { return pg8::cvt_pk_bf16(lo, hi); }
__device__ __forceinline__ float bflo(unsigned w) { return __builtin_bit_cast(float, w << 16); }
__device__ __forceinline__ float bfhi(unsigned w) { return __builtin_bit_cast(float, w & 0xffff0000u); }
__device__ __forceinline__ void unpack8(const u32x4 w, float (&v)[8]) { v[0] = bflo(w.x); v[1] = bfhi(w.x); v[2] = bflo(w.y); v[3] = bfhi(w.y); v[4] = bflo(w.z); v[5] = bfhi(w.z); v[6] = bflo(w.w); v[7] = bfhi(w.w); }
__device__ __forceinline__ u32x4 pack8(const float (&v)[8]) { u32x4 w; w.x = pk2(v[0], v[1]); w.y = pk2(v[2], v[3]); w.z = pk2(v[4], v[5]); w.w = pk2(v[6], v[7]); return w; }
#define DPP_F(v, ctrl) __builtin_bit_cast(float, __builtin_amdgcn_update_dpp(0, __builtin_bit_cast(int, (v)), (ctrl), 0xF, 0xF, true))
__device__ __forceinline__ float wave_sum(float v) {
    v += DPP_F(v, 0xB1); v += DPP_F(v, 0x4E); v += DPP_F(v, 0x141); v += DPP_F(v, 0x140);
    v += __shfl_xor(v, 16); v += __shfl_xor(v, 32);
    return v;
}

__device__ __forceinline__ float wave_max(float v) {
    v = fmaxf(v, DPP_F(v, 0xB1)); v = fmaxf(v, DPP_F(v, 0x4E)); v = fmaxf(v, DPP_F(v, 0x141)); v = fmaxf(v, DPP_F(v, 0x140));
    v = fmaxf(v, __shfl_xor(v, 16)); v = fmaxf(v, __shfl_xor(v, 32));
    return v;
}
__device__ __forceinline__ unsigned q4(float a, float b, float c, float d, float inv) {
    const int qa = (int)__builtin_rintf(a * inv), qb = (int)__builtin_rintf(b * inv), qc = (int)__builtin_rintf(c * inv), qd = (int)__builtin_rintf(d * inv);
    return (unsigned)(qa & 255) | ((unsigned)(qb & 255) << 8) | ((unsigned)(qc & 255) << 16) | ((unsigned)qd << 24);
}
__device__ __forceinline__ void ld_row16_bf16(const bf16_t* xrow, int lane, u32x4 (&w)[8]) { const GAS u32x4* xr = (const GAS u32x4*)xrow + 2 * lane;
#pragma unroll
    for (int j = 0; j < 4; ++j) { w[2 * j] = xr[128 * j]; w[2 * j + 1] = xr[128 * j + 1]; } }
__device__ __forceinline__ void unpack16(const u32x4 a, const u32x4 b, float (&v)[16]) {
    v[0] = bflo(a.x); v[1] = bfhi(a.x); v[2] = bflo(a.y); v[3] = bfhi(a.y); v[4] = bflo(a.z); v[5] = bfhi(a.z); v[6] = bflo(a.w); v[7] = bfhi(a.w);
    v[8] = bflo(b.x); v[9] = bfhi(b.x); v[10] = bflo(b.y); v[11] = bfhi(b.y); v[12] = bflo(b.z); v[13] = bfhi(b.z); v[14] = bflo(b.w); v[15] = bfhi(b.w); }
__device__ __forceinline__ void unpack16h(const u32x4 a, const u32x4 b, float (&v)[16]) {
    v[0] = pg8::hlo(a.x); v[1] = pg8::hhi(a.x); v[2] = pg8::hlo(a.y); v[3] = pg8::hhi(a.y); v[4] = pg8::hlo(a.z); v[5] = pg8::hhi(a.z); v[6] = pg8::hlo(a.w); v[7] = pg8::hhi(a.w);
    v[8] = pg8::hlo(b.x); v[9] = pg8::hhi(b.x); v[10] = pg8::hlo(b.y); v[11] = pg8::hhi(b.y); v[12] = pg8::hlo(b.z); v[13] = pg8::hhi(b.z); v[14] = pg8::hlo(b.w); v[15] = pg8::hhi(b.w); }
__device__ __forceinline__ void quant_row_store(const float (&h)[4][16], int lane, unsigned char* qrow, float* srow) {
    float mx = 0.f;
#pragma unroll
    for (int j = 0; j < 4; ++j)
#pragma unroll
        for (int e = 0; e < 16; ++e) mx = fmaxf(mx, fabsf(h[j][e]));
    mx = wave_max(mx);
    const float inv = mx > 0.f ? 127.0f / mx : 0.f;
#pragma unroll
    for (int j = 0; j < 4; ++j) { u32x4 w; w.x = q4(h[j][0], h[j][1], h[j][2], h[j][3], inv); w.y = q4(h[j][4], h[j][5], h[j][6], h[j][7], inv); w.z = q4(h[j][8], h[j][9], h[j][10], h[j][11], inv); w.w = q4(h[j][12], h[j][13], h[j][14], h[j][15], inv);
        *(GAS u32x4*)(qrow + 16 * (64 * j + lane)) = w; }
    if (lane == 0) *srow = mx * (1.0f / 127.0f);
}
__device__ __forceinline__ float quad_xor1(float v) { return __builtin_bit_cast(float, __builtin_amdgcn_update_dpp(0, __builtin_bit_cast(int, v), 0xB1, 0xF, 0xF, true)); }
__device__ __forceinline__ float quad_xor2(float v) { return __builtin_bit_cast(float, __builtin_amdgcn_update_dpp(0, __builtin_bit_cast(int, v), 0x4E, 0xF, 0xF, true)); }
__device__ __forceinline__ void hadamard64_row(float (&h)[4][16], int lane) {
#pragma unroll
    for (int j = 0; j < 4; ++j) {
#pragma unroll
        for (int s = 1; s < 16; s <<= 1)
#pragma unroll
            for (int i = 0; i < 16; ++i) if ((i & s) == 0) { const float a = h[j][i], b = h[j][i + s]; h[j][i] = a + b; h[j][i + s] = a - b; }
#pragma unroll
        for (int bit = 1; bit <= 2; bit <<= 1)
#pragma unroll
            for (int i = 0; i < 16; ++i) { const float p = (bit == 1) ? quad_xor1(h[j][i]) : quad_xor2(h[j][i]); h[j][i] = (lane & bit) ? (p - h[j][i]) : (h[j][i] + p); }
#pragma unroll
        for (int i = 0; i < 16; ++i) h[j][i] *= 0.125f;
    }
}
constexpr bool ROT5 = true;
constexpr bool ROT7 = true;
__device__ __forceinline__ void quant_wrow(const u32x4 (&w)[8], int lane, unsigned char* qrow, float* srow, bool rot = false) {
    float h[4][16];
#pragma unroll
    for (int j = 0; j < 4; ++j) unpack16(w[2 * j], w[2 * j + 1], h[j]);
    if (rot) hadamard64_row(h, lane);
    quant_row_store(h, lane, qrow, srow);
}

__device__ __forceinline__ void requant_r8_row(const unsigned char* src, const float* cs, int lane, unsigned char* qrow, float& scale) {
    float s[16]; float mx = 0.f;
#pragma unroll
    for (int j = 0; j < 16; ++j) { s[j] = *(const GAS float*)(cs + 16 * j + (lane >> 2)); mx = fmaxf(mx, s[j]); }
    mx = wave_max(mx);
    const float rm = 255.0f * mx, hm = rm * rm, inv = hm > 0.f ? 255.0f / hm : 0.f;
    const GAS u32x4* p = (const GAS u32x4*)src + lane;
#pragma unroll 1
    for (int j0 = 0; j0 < 16; j0 += 8) { u32x4 w[8];
#pragma unroll
        for (int j = 0; j < 8; ++j) w[j] = p[64 * (j0 + j)];
#pragma unroll
        for (int j = 0; j < 8; ++j) { const float sj = (j0 == 0) ? s[j] : s[8 + j], cj = sj * sj * inv; unsigned o[4];
#pragma unroll
            for (int d = 0; d < 4; ++d) { float q[4];
#pragma unroll
                for (int e = 0; e < 4; ++e) { const float t = (float)((w[j][d] >> (8 * e)) & 255u); q[e] = t * t; }
                o[d] = pg8::pack4_rne(q[0], q[1], q[2], q[3], cj) ^ 0x80808080u; }
            *(GAS u32x4*)(qrow + 16 * (64 * (j0 + j) + lane)) = (u32x4){o[0], o[1], o[2], o[3]}; } }
    scale = hm * (1.0f / 255.0f);
}
template <bool UNS> __device__ __forceinline__ void quant_wide_row(const bf16_t* src, int lane, unsigned char* qrow, float& scale, int& qsum, float given_max = -1.f) {
    const GAS u32x4* p = (const GAS u32x4*)src + 2 * lane;
    float mx = 0.f;
    if (given_max >= 0.f) mx = given_max;
    else
#pragma unroll 1
    for (int j0 = 0; j0 < 16; j0 += 8) { u32x4 w[16];
#pragma unroll
        for (int j = 0; j < 8; ++j) { w[2 * j] = p[128 * (j0 + j)]; w[2 * j + 1] = p[128 * (j0 + j) + 1]; }
#pragma unroll
        for (int j = 0; j < 8; ++j) { float v[16]; unpack16(w[2 * j], w[2 * j + 1], v);
#pragma unroll
            for (int e = 0; e < 16; ++e) mx = fmaxf(mx, fabsf(v[e])); } }
    if (given_max < 0.f) mx = wave_max(mx);
    const float lev = UNS ? 255.0f : 127.0f, inv = mx > 0.f ? lev / mx : 0.f;
    int isum = 0;
#pragma unroll 1
    for (int j0 = 0; j0 < 16; j0 += 8) { u32x4 w[16];
#pragma unroll
        for (int j = 0; j < 8; ++j) { w[2 * j] = p[128 * (j0 + j)]; w[2 * j + 1] = p[128 * (j0 + j) + 1]; }
#pragma unroll
        for (int j = 0; j < 8; ++j) { float v[16]; unpack16(w[2 * j], w[2 * j + 1], v); unsigned o[4];
#pragma unroll
            for (int d = 0; d < 4; ++d) { unsigned pk = 0u;
#pragma unroll
                for (int e = 0; e < 4; ++e) { const int q = (int)fminf(__builtin_rintf(v[4 * d + e] * inv), lev) - (UNS ? 128 : 0); isum += q; pk |= (unsigned)(q & 255) << (8 * e); }
                o[d] = pk; }
            *(GAS u32x4*)(qrow + 16 * (64 * (j0 + j) + lane)) = (u32x4){o[0], o[1], o[2], o[3]}; } }
#pragma unroll
    for (int o = 1; o < 64; o <<= 1) isum += __shfl_xor(isum, o);
    scale = mx / lev; qsum = isum;
}

#define XB_TMO      128
#define XB_XCNT(j)  (256  + 64 * (j))
#define XB_XSUB(j)  (1280 + 64 * (j))
#define XB_XGEN(j)  (2304 + 64 * (j))
#define XB_TOP      3328
#define XB_TOPGEN   3392
#define XCD_BAR_WORDS 3456
#define XB_SPIN_CAP (1u << 18)

__device__ __forceinline__ unsigned xb_ld(unsigned* p)              { return __hip_atomic_load(p, __ATOMIC_RELAXED, __HIP_MEMORY_SCOPE_AGENT); }
__device__ __forceinline__ unsigned xb_add(unsigned* p, unsigned v) { return __hip_atomic_fetch_add(p, v, __ATOMIC_RELAXED, __HIP_MEMORY_SCOPE_AGENT); }
__device__ __forceinline__ unsigned xb_xcc_id() { return (unsigned)__builtin_amdgcn_s_getreg((3 << 11) | 20) & 0xFu; }
#define XB_SPIN(cond, bar) do { unsigned _sp = 0; while (cond) { __builtin_amdgcn_s_sleep(1); \
    if ((++_sp & 255u) == 0u) { if (xb_ld(&(bar)[XB_TMO])) break; if (_sp > XB_SPIN_CAP) { atomicAdd(&(bar)[XB_TMO], 1u); break; } } } } while (0)

struct XcdBarrier {
    unsigned* bar; unsigned x;
    volatile LAS unsigned* st;
};
__device__ __forceinline__ XcdBarrier xcd_barrier_post(unsigned* bar, volatile LAS unsigned* st) {
    XcdBarrier b; b.bar = bar; b.x = xb_xcc_id(); b.st = st;
    if (threadIdx.x == 0) (void)xb_add(&bar[XB_XCNT(b.x)], 1u);
    return b;
}
__device__ __forceinline__ void xcd_barrier_complete(unsigned* bar, unsigned x, unsigned& nloc, unsigned& nx) {
    const unsigned G = gridDim.x * gridDim.y * gridDim.z;
    unsigned sum, cnt, mine, sp = 0u;
    for (;;) {
        sum = 0u; cnt = 0u; mine = 0u;
#pragma unroll
        for (unsigned j = 0; j < 16; ++j) { const unsigned c = xb_ld(&bar[XB_XCNT(j)]); sum += c; cnt += (c > 0u) ? 1u : 0u; mine = (j == x) ? c : mine; }
        if (sum == G) break;
        __builtin_amdgcn_s_sleep(1);
        if ((++sp & 255u) == 0u) { if (xb_ld(&bar[XB_TMO])) break; if (sp > XB_SPIN_CAP) { atomicAdd(&bar[XB_TMO], 1u); break; } }
    }
    nloc = mine > 0u ? mine : 1u; nx = cnt > 0u ? cnt : 1u;
}
__device__ __forceinline__ void xcd_barrier(const XcdBarrier& b) {
    asm volatile("s_waitcnt vmcnt(0)" ::: "memory");
    __syncthreads();
    if (threadIdx.x == 0) {
        unsigned* bar = b.bar;
        __builtin_amdgcn_s_waitcnt(0);
        unsigned nloc = b.st[0], nx = b.st[1];
        if (nloc == 0u) { xcd_barrier_complete(bar, b.x, nloc, nx); b.st[0] = nloc; b.st[1] = nx; }
        const unsigned old = xb_add(&bar[XB_XSUB(b.x)], 1u);
        const unsigned gen = old / nloc;
        if (old + 1u == (gen + 1u) * nloc) {
            __builtin_amdgcn_fence(__ATOMIC_RELEASE, "agent");
            asm volatile("s_waitcnt vmcnt(0)" ::: "memory");
            const unsigned og = xb_add(&bar[XB_TOP], 1u);
            const unsigned tg = og / nx;
            if (og + 1u == (tg + 1u) * nx) xb_add(&bar[XB_TOPGEN], 1u);
            else XB_SPIN(xb_ld(&bar[XB_TOPGEN]) == tg, bar);
            __builtin_amdgcn_fence(__ATOMIC_ACQUIRE, "agent");
            xb_add(&bar[XB_XGEN(b.x)], 1u);
            asm volatile("s_waitcnt vmcnt(0)" ::: "memory");
        } else {
            XB_SPIN(xb_ld(&bar[XB_XGEN(b.x)]) == gen, bar);
            __builtin_amdgcn_fence(__ATOMIC_ACQUIRE, "agent");
            asm volatile("s_waitcnt vmcnt(0)" ::: "memory");
        }
    }
    __syncthreads();
}

struct Args { const float* in[17]; float* out; unsigned char* ws; };
struct Frame {
    LAS unsigned char* lds;
    int tid, lane, wave, G, bx;
    const float *x, *c, *w_ada, *b_ada, *g1, *w_in, *pool_mix_w, *pool_scale, *conv_w, *conv_b, *gpool, *gconv, *w_out, *g2, *w1, *w2, *gfin;
    float* out;
    float *modpart, *modfull, *statsp, *stats1, *stats2;
    bf16_t *MixT, *WinT, *WoutT, *W1T, *W2T, *HB, *HID, *PROJ, *MIXED, *POOLED, *X1B;
    unsigned char *W1Q, *WoutQ, *H2Q, *MIXQ, *H1Q, *WinQ, *HIDQ, *W2Q; float *sA8, *sB2; int* cs2; unsigned* hmax; float *sBout, *sB1, *sA5, *sA7, *sA1, *sBin;
};

__device__ __forceinline__ void p0_ada_item(const Frame& F, int item) {
    const int cb = item % 96, ks = item / 96;
    const int k0 = ks * 512 + F.wave * 64, col = cb * 256 + F.lane * 4;
    float sv[4];
#pragma unroll
    for (int b = 0; b < 4; ++b) { const float cv = F.c[b * D + k0 + F.lane]; sv[b] = cv / (1.0f + expf(-cv)); }
    f32x4 acc[4];
#pragma unroll
    for (int b = 0; b < 4; ++b) acc[b] = (f32x4){0.f, 0.f, 0.f, 0.f};
    const GAS f32x4* wp = (const GAS f32x4*)(F.w_ada + (size_t)k0 * NMODW + col);
#pragma unroll 32
    for (int kk = 0; kk < 64; ++kk) {
        const f32x4 w = wp[(size_t)kk * (NMODW / 4)];
#pragma unroll
        for (int b = 0; b < 4; ++b) { const float s = __builtin_bit_cast(float, __builtin_amdgcn_readlane(__builtin_bit_cast(int, sv[b]), kk)); acc[b] += w * s; }
    }
    LAS float* red = (LAS float*)F.lds;
#pragma unroll
    for (int b = 0; b < 4; ++b) *(LAS f32x4*)(red + (F.wave * 4 + b) * 256 + F.lane * 4) = acc[b];
    __syncthreads();
#pragma unroll
    for (int h = 0; h < 2; ++h) { const int o = F.tid + h * 512, b = o >> 8, cc = o & 255; float s = 0.f;
#pragma unroll
        for (int w = 0; w < 8; ++w) s += red[(w * 4 + b) * 256 + cc];
        const int n = cb * 256 + cc;
        if (ks == 0) s += F.b_ada[n];
        F.modpart[(size_t)(ks * 4 + b) * NMODW + n] = s; }
    __syncthreads();
}
struct TItem { const float* W; bf16_t* WT; int K, N, r, perm; };
__device__ __forceinline__ void p0_titem_load(const TItem& t, int lane, f32x4 (&v)[8]) {
    const int nblk = t.N / 32, kb = t.r / nblk, nb = t.r % nblk, k0 = 64 * kb, n0 = 32 * nb;
    const GAS float* src = (const GAS float*)t.W + (size_t)(k0 + (lane >> 3)) * t.N + n0 + 4 * (lane & 7);
#pragma unroll
    for (int i = 0; i < 8; ++i) v[i] = *(const GAS f32x4*)(src + (size_t)(8 * i) * t.N);
}
__device__ __forceinline__ void p0_titem_store(const TItem& t, int lane, const f32x4 (&v)[8], LAS float* scr) {
    const int nblk = t.N / 32, kb = t.r / nblk, nb = t.r % nblk, k0 = 64 * kb, n0 = 32 * nb;
#pragma unroll
    for (int i = 0; i < 8; ++i)
#pragma unroll
        for (int e = 0; e < 4; ++e) scr[(8 * i + (lane >> 3)) * 33 + 4 * (lane & 7) + e] = v[i][e];
    LDS_WAIT(); asm volatile("" ::: "memory");
    const int c = lane & 7;
    int n0d = n0;
    if (t.perm && n0 >= 2 * PW) { const int isu = n0 >= 3 * PW, ch = n0 - (isu ? 3 * PW : 2 * PW); n0d = 2 * PW + 256 * (ch >> 7) + 128 * isu + (ch & 127); }
#pragma unroll
    for (int j = 0; j < 4; ++j) { const int n = (lane >> 3) + 8 * j; const LAS float* s = scr + (8 * c) * 33 + n;
        u32x4 o; o.x = pk2(s[0 * 33], s[1 * 33]); o.y = pk2(s[2 * 33], s[3 * 33]); o.z = pk2(s[4 * 33], s[5 * 33]); o.w = pk2(s[6 * 33], s[7 * 33]);
        *(GAS u32x4*)(t.WT + (size_t)(n0d + n) * t.K + k0 + 8 * c) = o; }
    LDS_WAIT(); asm volatile("" ::: "memory");
}
__device__ __forceinline__ TItem p0_titem(const Frame& F, int it) {
    constexpr int I_IN = (D / 64) * (NPROJ / 32), I_OUT = (D / 64) * (D / 32), I_1 = (D / 64) * (FF / 32), I_2 = (FF / 64) * (D / 32), I_MIX = (PGD / 64) * (PGD / 32);
    int r = it;
    if (r < I_IN) return TItem{F.w_in, F.WinT, D, NPROJ, r, 1}; r -= I_IN;
    if constexpr (!PANEL_P0) {
    if (r < I_OUT) return TItem{F.w_out, F.WoutT, D, D, r, 0}; r -= I_OUT;
    if (r < I_1) return TItem{F.w1, F.W1T, D, FF, r, 0}; r -= I_1; }
    if (r < I_2) return TItem{F.w2, F.W2T, FF, D, r, 0}; r -= I_2;
    const int g = r / I_MIX; r -= g * I_MIX;
    return TItem{F.pool_mix_w + (size_t)g * PGD * PGD, F.MixT + (size_t)g * PGD * PGD, PGD, PGD, r, 0};
}
constexpr int PANEL_PITCH = 8208;
__device__ __forceinline__ int panel_row_off(int n) { return n * PANEL_PITCH + (n == 15 ? (RING_BYTES + 1024) - 15 * PANEL_PITCH : 0); }
struct Panel { const float* W; int N, n0; unsigned char* Q; float* sc; bool rot; };
__device__ __forceinline__ Panel p0_panel_of(const Frame& F, int p) {
    if (p < D / 16) return Panel{F.w_out, D, 16 * p, F.WoutQ, F.sBout, ROT5};
    return Panel{F.w1, FF, 16 * (p - D / 16), F.W1Q, F.sB1, ROT7};
}
__device__ __forceinline__ void p0_panels(const Frame& F, int first, int step, int npan) {
    if (first >= npan) return;
    const int r = F.lane >> 2, c4 = F.lane & 3;
    int woff[4];
#pragma unroll
    for (int e = 0; e < 4; ++e) woff[e] = panel_row_off(4 * c4 + e) + (512 * F.wave + 2 * r) * 2;
    f32x4 va[2][4], vb[2][4];
#define P0C_SRC(pn) ((const GAS float*)(pn).W + (size_t)(512 * F.wave + 2 * r) * (pn).N + (pn).n0 + 4 * c4)
#define P0C_LOAD(buf, b, s, N_) do { _Pragma("unroll") for (int t = 0; t < 4; ++t) { va[buf][t] = *(const GAS f32x4*)((s) + (size_t)(32 * (4 * (b) + t)) * (N_)); vb[buf][t] = *(const GAS f32x4*)((s) + (size_t)(32 * (4 * (b) + t) + 1) * (N_)); } } while (0)
#define P0C_PUT(buf, b) do { _Pragma("unroll") for (int t = 0; t < 4; ++t) _Pragma("unroll") for (int e = 0; e < 4; ++e) *(LAS unsigned*)(F.lds + woff[e] + 64 * (4 * (b) + t)) = pk2(va[buf][t][e], vb[buf][t][e]); } while (0)
    int p = first;
    { const Panel cur = p0_panel_of(F, p); const GAS float* s = P0C_SRC(cur); P0C_LOAD(0, 0, s, cur.N); P0C_LOAD(1, 1, s, cur.N); }
    for (;;) {
        const Panel cur = p0_panel_of(F, p);
        { const GAS float* s = P0C_SRC(cur); P0C_PUT(0, 0); P0C_LOAD(0, 2, s, cur.N); P0C_PUT(1, 1); P0C_LOAD(1, 3, s, cur.N); P0C_PUT(0, 2); P0C_PUT(1, 3); }
        LDS_WAIT(); __builtin_amdgcn_s_barrier();
        const int pn = p + step; const bool has = pn < npan;
        if (has) { const Panel nx = p0_panel_of(F, pn); const GAS float* s = P0C_SRC(nx); P0C_LOAD(0, 0, s, nx.N); P0C_LOAD(1, 1, s, nx.N); }
#pragma unroll 1
        for (int q = 0; q < 2; ++q) { const int n = 2 * F.wave + q; const LAS unsigned char* rowp = F.lds + panel_row_off(n) + 32 * F.lane; u32x4 w[8];
#pragma unroll
            for (int j = 0; j < 4; ++j) { w[2 * j] = *(const LAS u32x4*)(rowp + 2048 * j); w[2 * j + 1] = *(const LAS u32x4*)(rowp + 2048 * j + 16); }
            quant_wrow(w, F.lane, cur.Q + (size_t)(cur.n0 + n) * D, cur.sc + cur.n0 + n, cur.rot); }
        LDS_WAIT(); __builtin_amdgcn_s_barrier();
        if (!has) break;
        p = pn;
    }
#undef P0C_SRC
#undef P0C_LOAD
#undef P0C_PUT
}
__device__ __forceinline__ void p0_prologue(const Frame& F) {
    for (int item = F.bx; item < 96 * 8; item += F.G) p0_ada_item(F, item);
    __syncthreads();
    if constexpr (PANEL_P0) {
        constexpr int NPAN = D / 16 + FF / 16;
        const bool paired = (F.G & 15) == 0;
        const int PP = (NPAN / 2 + F.G / 2 - 1) / (F.G / 2), q = (F.bx & 7) + 8 * (F.bx >> 4);
        const int first = paired ? 2 * (q * PP) + ((F.bx >> 3) & 1) : F.bx, step = paired ? 2 : F.G, last = paired ? (2 * (q * PP + PP) < NPAN ? 2 * (q * PP + PP) : NPAN) : NPAN;
        p0_panels(F, first, step, last);
    }
    LAS float* scr = (LAS float*)(F.lds + F.wave * 16384);
    const int gw = F.bx * NWAVES + F.wave, NGW = F.G * NWAVES;
    constexpr int NITEMS = (D / 64) * (NPROJ / 32) + (PANEL_P0 ? 0 : (D / 64) * (D / 32) + (D / 64) * (FF / 32)) + (FF / 64) * (D / 32) + 4 * (PGD / 64) * (PGD / 32);
    int it = gw;
    if (it < NITEMS) {
        TItem cur = p0_titem(F, it); f32x4 v[8]; p0_titem_load(cur, F.lane, v);
        for (;;) {
            const int nit = it + NGW; const bool has = nit < NITEMS;
            TItem nx = cur; f32x4 vn[8];
            if (has) { nx = p0_titem(F, nit); p0_titem_load(nx, F.lane, vn); }
            p0_titem_store(cur, F.lane, v, scr);
            if (!has) break;
            cur = nx; it = nit;
#pragma unroll
            for (int i = 0; i < 8; ++i) v[i] = vn[i];
        }
    }
}

__device__ __forceinline__ void ld_row_f32(const float* xrow, int lane, f32x4 (&v)[16]) { const GAS f32x4* xr = (const GAS f32x4*)xrow + 2 * lane;
#pragma unroll
    for (int j = 0; j < 8; ++j) { v[2 * j] = xr[128 * j]; v[2 * j + 1] = xr[128 * j + 1]; } }
__device__ __forceinline__ void ld_row_bf16(const bf16_t* xrow, int lane, u32x4 (&w)[8]) { const GAS u32x4* xr = (const GAS u32x4*)xrow + lane;
#pragma unroll
    for (int j = 0; j < 8; ++j) w[j] = xr[64 * j]; }
__device__ __forceinline__ void norm_mod_finish_f32(const f32x4 (&v)[16], int lane, bf16_t* orow, const LAS float* av, const LAS float* sv) {
    float ss = 0.f;
#pragma unroll
    for (int j = 0; j < 16; ++j) ss += (v[j][0] * v[j][0] + v[j][1] * v[j][1]) + (v[j][2] * v[j][2] + v[j][3] * v[j][3]);
    ss = wave_sum(ss);
    const float rs = 1.0f / sqrtf(ss * (1.0f / D) + EPS);
    GAS u32x4* o16 = (GAS u32x4*)orow + lane;
#pragma unroll
    for (int j = 0; j < 8; ++j) { const int col = 8 * (64 * j + lane);
        const f32x4 a0 = *(const LAS f32x4*)(av + col), a1 = *(const LAS f32x4*)(av + col + 4), s0 = *(const LAS f32x4*)(sv + col), s1 = *(const LAS f32x4*)(sv + col + 4);
        const f32x4 o0 = v[2 * j] * rs * a0 + s0, o1 = v[2 * j + 1] * rs * a1 + s1;
        u32x4 w; w.x = pk2(o0[0], o0[1]); w.y = pk2(o0[2], o0[3]); w.z = pk2(o1[0], o1[1]); w.w = pk2(o1[2], o1[3]); o16[64 * j] = w; }
}
__device__ __forceinline__ void norm_mod_finish_bf16(const u32x4 (&w)[8], int lane, bf16_t* orow, const LAS float* av, const LAS float* sv, float ss) {
    const float rs = 1.0f / sqrtf(ss * (1.0f / D) + EPS);
    GAS u32x4* o16 = (GAS u32x4*)orow + lane;
#pragma unroll
    for (int j = 0; j < 8; ++j) { const int col = 8 * (64 * j + lane); float v[8]; unpack8(w[j], v);
        const f32x4 a0 = *(const LAS f32x4*)(av + col), a1 = *(const LAS f32x4*)(av + col + 4), s0 = *(const LAS f32x4*)(sv + col), s1 = *(const LAS f32x4*)(sv + col + 4);
#pragma unroll
        for (int e = 0; e < 4; ++e) { v[e] = v[e] * rs * a0[e] + s0[e]; v[4 + e] = v[4 + e] * rs * a1[e] + s1[e]; }
        o16[64 * j] = pack8(v); }
}

__device__ __forceinline__ void ld_row16_f32(const float* xrow, int lane, f32x4 (&v)[16]) { const GAS f32x4* xr = (const GAS f32x4*)xrow + 4 * lane;
#pragma unroll
    for (int j = 0; j < 4; ++j)
#pragma unroll
        for (int i = 0; i < 4; ++i) v[4 * j + i] = xr[256 * j + i]; }
__device__ __forceinline__ void st_row16_bf16(const float (&h)[4][16], int lane, bf16_t* orow) { GAS u32x4* o16 = (GAS u32x4*)orow + 2 * lane;
#pragma unroll
    for (int j = 0; j < 4; ++j) { u32x4 a, b; a.x = pk2(h[j][0], h[j][1]); a.y = pk2(h[j][2], h[j][3]); a.z = pk2(h[j][4], h[j][5]); a.w = pk2(h[j][6], h[j][7]);
        b.x = pk2(h[j][8], h[j][9]); b.y = pk2(h[j][10], h[j][11]); b.z = pk2(h[j][12], h[j][13]); b.w = pk2(h[j][14], h[j][15]); o16[128 * j] = a; o16[128 * j + 1] = b; } }

__device__ __forceinline__ void ld8(const bf16_t* p, float (&v)[8]) { const u32x4 w = *(const GAS u32x4*)p; unpack8(w, v); }
__device__ __forceinline__ void p3_pool_item(const Frame& F, int tt, int g) {
    const int row0 = tt * 32, b = row0 >> 12, t0 = row0 & (SEQ - 1), h = 1 << g;
    const bf16_t* base = F.PROJ + (size_t)(b * SEQ) * PJ + PGD * g + 8 * F.lane;
    bf16_t* obase = F.POOLED + (size_t)(b * SEQ) * PW + PGD * g + 8 * F.lane;
    float S[8];
#pragma unroll
    for (int e = 0; e < 8; ++e) S[e] = 0.f;
    const int jlo = (t0 - h) > 0 ? (t0 - h) : 0, jhi = (t0 + h) < SEQ ? (t0 + h) : SEQ;
    for (int j = jlo; j < jhi; ++j) { float v[8]; ld8(base + (size_t)j * PJ, v);
#pragma unroll
        for (int e = 0; e < 8; ++e) S[e] += v[e]; }
#pragma unroll 8
    for (int i = 0; i < 32; ++i) { const int t = t0 + i;
        const int lo = (t - h) > 0 ? (t - h) : 0, hi = (t + h) < SEQ ? (t + h) : SEQ; const float inv = 1.0f / (float)(hi - lo);
        float vt[8], va[8], vs[8];
        ld8(base + (size_t)t * PJ, vt);
        const int ta = (t + h) < SEQ ? (t + h) : (SEQ - 1), ts = (t - h) > 0 ? (t - h) : 0;
        const float ma = (t + h) < SEQ ? 1.f : 0.f, ms = (t - h) >= 0 ? 1.f : 0.f;
        ld8(base + (size_t)ta * PJ, va); ld8(base + (size_t)ts * PJ, vs);
        float o[8];
#pragma unroll
        for (int e = 0; e < 8; ++e) { o[e] = S[e] * inv - vt[e]; S[e] += ma * va[e] - ms * vs[e]; }
        *(GAS u32x4*)(obase + (size_t)t * PW) = pack8(o); }
}
__device__ __forceinline__ void p3_conv_item(const Frame& F, int tt, int q) {
    const int row0 = tt * 32, b = row0 >> 12, t0 = row0 & (SEQ - 1), ch = 512 * q + 8 * F.lane;
    const bf16_t* pb = F.PROJ + (size_t)(b * SEQ) * PJ + PW + ch; const bf16_t* pcu = pb + CW;
    bf16_t* obase = F.MIXED + (size_t)(b * SEQ) * D + PW + ch;
    float w0[8], w1[8], w2[8], bs[8], gn[8];
#pragma unroll
    for (int e = 0; e < 8; ++e) { w0[e] = F.conv_w[ch + e]; w1[e] = F.conv_w[CW + ch + e]; w2[e] = F.conv_w[2 * CW + ch + e]; bs[e] = F.conv_b[ch + e]; gn[e] = F.gconv[ch + e]; }
    float cup[8], cuc[8], cun[8];
    { const int tp = t0 > 0 ? t0 - 1 : 0; const float mp = t0 > 0 ? 1.f : 0.f;
      ld8(pcu + (size_t)tp * PJ, cup);
#pragma unroll
      for (int e = 0; e < 8; ++e) cup[e] *= mp;
      ld8(pcu + (size_t)t0 * PJ, cuc); }
#pragma unroll 8
    for (int i = 0; i < 32; ++i) { const int t = t0 + i; const int tn = (t + 1) < SEQ ? (t + 1) : (SEQ - 1); const float mn = (t + 1) < SEQ ? 1.f : 0.f;
        float bg[8];
        ld8(pcu + (size_t)tn * PJ, cun); ld8(pb + (size_t)t * PJ, bg);
        float o[8]; float ss = 0.f;
#pragma unroll
        for (int e = 0; e < 8; ++e) { cun[e] *= mn; const float cv = w0[e] * cup[e] + w1[e] * cuc[e] + w2[e] * cun[e] + bs[e]; o[e] = bg[e] * cv; ss += o[e] * o[e]; cup[e] = cuc[e]; cuc[e] = cun[e]; }
        ss += DPP_F(ss, 0xB1); ss += DPP_F(ss, 0x4E); ss += DPP_F(ss, 0x141); ss += DPP_F(ss, 0x140);
        const float rs = 1.0f / sqrtf(ss * (1.0f / 128.0f) + EPS);
#pragma unroll
        for (int e = 0; e < 8; ++e) o[e] = o[e] * rs * gn[e];
        *(GAS u32x4*)(obase + (size_t)t * D) = pack8(o); }
}

__device__ __forceinline__ void relaunder(Frame& F) { int t = F.tid; asm volatile("" : "+v"(t)); F.tid = t; F.lane = t & 63; }
__global__ void __launch_bounds__(NWAVES * 64, 2) fwd_kernel(Args args) {
    extern __shared__ __attribute__((aligned(16))) unsigned char lds_raw[];
    Frame F;
    F.lds = (LAS unsigned char*)lds_raw;
    F.tid = threadIdx.x; F.lane = F.tid & 63; F.wave = __builtin_amdgcn_readfirstlane(F.tid >> 6);
    F.G = gridDim.x; F.bx = blockIdx.x;
    unsigned char* ws = args.ws;
    F.x = args.in[0]; F.c = args.in[1]; F.w_ada = args.in[2]; F.b_ada = args.in[3]; F.g1 = args.in[4]; F.w_in = args.in[5]; F.pool_mix_w = args.in[6]; F.pool_scale = args.in[7];
    F.conv_w = args.in[8]; F.conv_b = args.in[9]; F.gpool = args.in[10]; F.gconv = args.in[11]; F.w_out = args.in[12]; F.g2 = args.in[13]; F.w1 = args.in[14]; F.w2 = args.in[15]; F.gfin = args.in[16];
    F.out = args.out; F.X1B = (bf16_t*)args.out;
    F.modpart = (float*)(ws + WS_MODPART); F.modfull = (float*)(ws + WS_MODFULL); F.statsp = (float*)(ws + WS_STATSP); F.stats1 = (float*)(ws + WS_STATS1); F.stats2 = (float*)(ws + WS_STATS2);
    F.MixT = (bf16_t*)(ws + WS_MIXT); F.WinT = (bf16_t*)(ws + WS_WIN); F.WoutT = (bf16_t*)(ws + WS_WOUT); F.W1T = (bf16_t*)(ws + WS_W1); F.W2T = (bf16_t*)(ws + WS_W2);
    F.HB = (bf16_t*)(ws + WS_HB); F.HID = (bf16_t*)(ws + WS_HID); F.PROJ = (bf16_t*)(ws + WS_PROJ); F.MIXED = (bf16_t*)(ws + WS_MIXED); F.POOLED = (bf16_t*)(ws + WS_POOLED);
    F.W1Q = ws + WS_W1Q; F.WoutQ = ws + WS_WOUTQ; F.H2Q = (unsigned char*)args.out + 128 * MiB; F.MIXQ = ws + WS_MIXQ;
    F.HIDQ = ws + WS_HIDQ; F.W2Q = (unsigned char*)args.out + 192 * MiB; F.sA8 = (float*)(ws + WS_SA8); F.sB2 = (float*)(ws + WS_SB2); F.cs2 = (int*)(ws + WS_CS2); F.hmax = (unsigned*)(ws + WS_HMAX);
    F.H1Q = F.H2Q; F.WinQ = ws + WS_WINQ; F.sA1 = (float*)(ws + WS_SA1); F.sBin = (float*)(ws + WS_SBIN);
    F.sBout = (float*)(ws + WS_SBOUT); F.sB1 = (float*)(ws + WS_SB1); F.sA5 = (float*)(ws + WS_SA5); F.sA7 = (float*)(ws + WS_SA7);
    volatile LAS unsigned* MISC = (volatile LAS unsigned*)(F.lds + MISC_OFF);
    if (F.tid < 16) MISC[F.tid] = 0u;
    __syncthreads();
    XcdBarrier bar = xcd_barrier_post((unsigned*)(ws + WS_CTL), MISC);
    const int gw = F.bx * NWAVES + F.wave, NGW = F.G * NWAVES;
    LAS float* av = (LAS float*)F.lds;
    LAS float* sv = (LAS float*)(F.lds + 16384);

    relaunder(F);
    p0_prologue(F);
    xcd_barrier(bar);

    relaunder(F);
    for (int idx = F.bx * 512 + F.tid; idx < BATCH * NMODW; idx += F.G * 512) { float s = 0.f;
#pragma unroll
        for (int ks = 0; ks < 8; ++ks) s += F.modpart[(size_t)ks * BATCH * NMODW + idx];
        F.modfull[idx] = s; }
    for (int chunk = F.bx; chunk < M / 64; chunk += F.G) {
        const int b = chunk >> 6;
#pragma unroll
        for (int c4 = 0; c4 < 2; ++c4) { const int ci = 4 * (F.tid + 512 * c4); f32x4 sh = {0.f, 0.f, 0.f, 0.f}, sc = {0.f, 0.f, 0.f, 0.f};
#pragma unroll
            for (int ks = 0; ks < 8; ++ks) { const float* mp = F.modpart + (size_t)(ks * 4 + b) * NMODW; sh += *(const GAS f32x4*)(mp + ci); sc += *(const GAS f32x4*)(mp + D + ci); }
            *(LAS f32x4*)(av + ci) = *(const GAS f32x4*)(F.g1 + ci) * (1.0f + sc); *(LAS f32x4*)(sv + ci) = sh; }
        __syncthreads();
        { const int rbeg = chunk * 64 + F.wave * 8;
#pragma unroll 1
          for (int q = 0; q < 8; ++q) { const int row = rbeg + q;
              f32x4 v[16]; ld_row16_f32(F.x + (size_t)row * D, F.lane, v);
              float ss = 0.f;
#pragma unroll
              for (int j = 0; j < 16; ++j) ss += (v[j][0] * v[j][0] + v[j][1] * v[j][1]) + (v[j][2] * v[j][2] + v[j][3] * v[j][3]);
              const float rs = 1.0f / sqrtf(wave_sum(ss) * (1.0f / D) + EPS);
              float h[4][16];
#pragma unroll
              for (int j = 0; j < 4; ++j) { const int col = 16 * (64 * j + F.lane);
#pragma unroll
                  for (int e4 = 0; e4 < 4; ++e4) { const f32x4 a = *(const LAS f32x4*)(av + col + 4 * e4), s = *(const LAS f32x4*)(sv + col + 4 * e4);
#pragma unroll
                      for (int e = 0; e < 4; ++e) h[j][4 * e4 + e] = v[4 * j + e4][e] * rs * a[e] + s[e]; }
                  __builtin_amdgcn_sched_barrier(0); }
              st_row16_bf16(h, F.lane, F.HB + (size_t)row * D);
              if constexpr (NQ2 > 0) quant_row_store(h, F.lane, F.H1Q + (size_t)row * D, F.sA1 + row); } }
        __syncthreads();
    }
    if constexpr (NQ2 > 0) {
        for (int r = gw; r < 256 * NQ2; r += NGW) { u32x4 w[8]; ld_row16_bf16(F.WinT + (size_t)r * D, F.lane, w); quant_wrow(w, F.lane, F.WinQ + (size_t)r * D, F.sBin + r); } }
    xcd_barrier(bar);

    if constexpr (NQ2 > 0) { pg8::Gemm g{(const bf16_t*)F.H1Q, (const bf16_t*)F.WinQ, D / 2, D / 2, D / 2}; pg8::StaticOrder S; S.init(M, 256 * NQ2, F.G, F.bx);
      pg8::EpiProjI8 E{F.PROJ, F.sA1, F.sBin};
      pg8::gemm_phase<pg8::EpiProjI8, pg8::StaticOrder>(F.lds, g, S, E); }
    { pg8::Gemm g{F.HB, F.WinT + (size_t)256 * NQ2 * D, D, D, D}; pg8::StaticOrder S; S.init(M, NPROJ - 256 * NQ2, F.G, F.bx);
      pg8::EpiProj E{F.PROJ, NQ2};
      pg8::gemm_phase<pg8::EpiProj, pg8::StaticOrder>(F.lds, g, S, E); }
    xcd_barrier(bar);

    relaunder(F);
    for (int it = gw; it < 4096; it += NGW) {
        if (it < 2048) p3_pool_item(F, it >> 2, it & 3); else p3_conv_item(F, (it - 2048) >> 2, (it - 2048) & 3);
    }
    if constexpr (!PANEL_P0) { constexpr int RW5 = I8_P5 ? D : 0, RW = RW5 + 256 * NQ7;
      int r = gw; u32x4 wcur[8];
      if (r < RW) ld_row16_bf16((r < RW5) ? F.WoutT + (size_t)r * D : F.W1T + (size_t)(r - RW5) * D, F.lane, wcur);
#pragma unroll 1
      for (; r < RW; r += NGW) { const int rn = r + NGW; u32x4 wnx[8];
          if (rn < RW) ld_row16_bf16((rn < RW5) ? F.WoutT + (size_t)rn * D : F.W1T + (size_t)(rn - RW5) * D, F.lane, wnx);
          if (r < RW5) quant_wrow(wcur, F.lane, F.WoutQ + (size_t)r * D, F.sBout + r, ROT5); else quant_wrow(wcur, F.lane, F.W1Q + (size_t)(r - RW5) * D, F.sB1 + (r - RW5), ROT7);
          if (rn < RW) {
#pragma unroll
              for (int i = 0; i < 8; ++i) wcur[i] = wnx[i]; } } }
    if constexpr (I8_P8) {
        for (int r = gw; r < D; r += NGW) { float sc; int qs; quant_wide_row<false>(F.W2T + (size_t)r * FF, F.lane, F.W2Q + (size_t)r * FF, sc, qs);
            if (F.lane == 0) { F.sB2[r] = sc; F.cs2[r] = qs; } } }
    xcd_barrier(bar);

    { pg8::Gemm g{F.POOLED, F.MixT, PGD, PW, PGD}; pg8::StaticOrder S; S.init(M, PW, F.G, F.bx, 1, PGD);
      pg8::EpiPoolMix E{F.MIXED, D, F.pool_scale, F.statsp};
      pg8::gemm_phase<pg8::EpiPoolMix, pg8::StaticOrder>(F.lds, g, S, E); }
    xcd_barrier(bar);

    relaunder(F);
    if constexpr (I8_P5) {
    { float gp[2][16];
#pragma unroll
      for (int j = 0; j < 2; ++j)
#pragma unroll
          for (int e = 0; e < 16; ++e) gp[j][e] = F.gpool[16 * (64 * j + F.lane) + e];
      const int rows_per = M / NGW, rbeg = gw * rows_per;
      u32x4 wcur[8]; float stc = (F.lane < 32) ? F.statsp[(size_t)rbeg * 32 + F.lane] : 0.f; ld_row16_bf16(F.MIXED + (size_t)rbeg * D, F.lane, wcur);
#pragma unroll 1
      for (int q = 0; q < rows_per; ++q) { const int row = rbeg + q; u32x4 wnx[8]; float stn = 0.f;
          if (q + 1 < rows_per) { stn = (F.lane < 32) ? F.statsp[(size_t)(row + 1) * 32 + F.lane] : 0.f; ld_row16_bf16(F.MIXED + (size_t)(row + 1) * D, F.lane, wnx); }
          float s = stc; s += __shfl_xor(s, 1); s += __shfl_xor(s, 2); s += __shfl_xor(s, 4);
          float rsg[4];
#pragma unroll
          for (int g = 0; g < 4; ++g) { const float ssg = __builtin_bit_cast(float, __builtin_amdgcn_readlane(__builtin_bit_cast(int, s), 8 * g)); rsg[g] = 1.0f / sqrtf(ssg * (1.0f / PGD) + EPS); }
          float h[4][16];
#pragma unroll
          for (int j = 0; j < 4; ++j) unpack16(wcur[2 * j], wcur[2 * j + 1], h[j]);
#pragma unroll
          for (int j = 0; j < 2; ++j) { const float rs = (F.lane < 32) ? rsg[2 * j] : rsg[2 * j + 1];
#pragma unroll
              for (int e = 0; e < 16; ++e) h[j][e] = h[j][e] * rs * gp[j][e]; }
          if constexpr (ROT5) hadamard64_row(h, F.lane);
          quant_row_store(h, F.lane, F.MIXQ + (size_t)row * D, F.sA5 + row);
          if (q + 1 < rows_per) { stc = stn;
#pragma unroll
              for (int i = 0; i < 8; ++i) wcur[i] = wnx[i]; } } }
    } else {
    { float gp[4][8];
#pragma unroll
      for (int g = 0; g < 4; ++g)
#pragma unroll
          for (int e = 0; e < 8; ++e) gp[g][e] = F.gpool[PGD * g + 8 * F.lane + e];
      for (int row0 = gw * 8; row0 < M; row0 += 8 * NGW) {
          u32x4 w[8][4]; float st[8];
#pragma unroll
          for (int q = 0; q < 8; ++q) { const int row = row0 + q;
              if (row < M) { st[q] = (F.lane < 32) ? F.statsp[(size_t)row * 32 + F.lane] : 0.f; const bf16_t* p = F.MIXED + (size_t)row * D + 8 * F.lane;
#pragma unroll
                  for (int g = 0; g < 4; ++g) w[q][g] = *(const GAS u32x4*)(p + PGD * g); } }
#pragma unroll
          for (int q = 0; q < 8; ++q) { const int row = row0 + q;
              if (row < M) { float s = st[q]; s += __shfl_xor(s, 1); s += __shfl_xor(s, 2); s += __shfl_xor(s, 4);
                  bf16_t* p = F.MIXED + (size_t)row * D + 8 * F.lane;
#pragma unroll
                  for (int g = 0; g < 4; ++g) { const float ssg = __builtin_bit_cast(float, __builtin_amdgcn_readlane(__builtin_bit_cast(int, s), 8 * g));
                      const float rs = 1.0f / sqrtf(ssg * (1.0f / PGD) + EPS);
                      float v[8]; unpack8(w[q][g], v);
#pragma unroll
                      for (int e = 0; e < 8; ++e) v[e] = v[e] * rs * gp[g][e];
                      *(GAS u32x4*)(p + PGD * g) = pack8(v); } } } } }
    }
    xcd_barrier(bar);

    if constexpr (I8_P5) { pg8::Gemm g{(const bf16_t*)F.MIXQ, (const bf16_t*)F.WoutQ, D / 2, D / 2, D / 2}; pg8::StaticOrder S; S.init(M, D, F.G, F.bx);
      pg8::EpiResidI8 E{F.x, F.X1B, F.modfull + 2 * D, F.stats1, F.sA5, F.sBout};
      pg8::gemm_phase<pg8::EpiResidI8, pg8::StaticOrder>(F.lds, g, S, E); }
    else { pg8::Gemm g{F.MIXED, F.WoutT, D, D, D}; pg8::StaticOrder S; S.init(M, D, F.G, F.bx);
      pg8::EpiResid<false> E{F.x, F.X1B, F.modfull + 2 * D, F.stats1};
      pg8::gemm_phase<pg8::EpiResid<false>, pg8::StaticOrder>(F.lds, g, S, E); }
    xcd_barrier(bar);

    relaunder(F);
    for (int chunk = F.bx; chunk < M / 64; chunk += F.G) {
        const int b = chunk >> 6; const float* mp = F.modfull + (size_t)b * NMODW;
#pragma unroll
        for (int c4 = 0; c4 < 2; ++c4) { const int ci = 4 * (F.tid + 512 * c4);
            *(LAS f32x4*)(av + ci) = *(const GAS f32x4*)(F.g2 + ci) * (1.0f + *(const GAS f32x4*)(mp + 4 * D + ci)); *(LAS f32x4*)(sv + ci) = *(const GAS f32x4*)(mp + 3 * D + ci); }
        __syncthreads();
        { const int rbeg = chunk * 64 + F.wave * 8;
          u32x4 wcur[8]; float stc = F.stats1[(size_t)rbeg * 64 + F.lane]; ld_row16_bf16(F.X1B + (size_t)rbeg * D, F.lane, wcur);
#pragma unroll 1
          for (int q = 0; q < 8; ++q) { const int row = rbeg + q; u32x4 wnx[8]; float stn = 0.f;
              if (q + 1 < 8) { stn = F.stats1[(size_t)(row + 1) * 64 + F.lane]; ld_row16_bf16(F.X1B + (size_t)(row + 1) * D, F.lane, wnx); }
              const float rs = 1.0f / sqrtf(wave_sum(stc) * (1.0f / D) + EPS);
              float h[4][16];
#pragma unroll
              for (int j = 0; j < 4; ++j) { unpack16h(wcur[2 * j], wcur[2 * j + 1], h[j]); const int col = 16 * (64 * j + F.lane);
#pragma unroll
                  for (int e4 = 0; e4 < 4; ++e4) { const f32x4 a = *(const LAS f32x4*)(av + col + 4 * e4), s = *(const LAS f32x4*)(sv + col + 4 * e4);
#pragma unroll
                      for (int e = 0; e < 4; ++e) h[j][4 * e4 + e] = h[j][4 * e4 + e] * rs * a[e] + s[e]; }
                  __builtin_amdgcn_sched_barrier(0); }
              if constexpr (NQ7 < 64) { GAS u32x4* o16 = (GAS u32x4*)(F.HB + (size_t)row * D) + 2 * F.lane;
#pragma unroll
                  for (int j = 0; j < 4; ++j) { u32x4 a, b; a.x = pk2(h[j][0], h[j][1]); a.y = pk2(h[j][2], h[j][3]); a.z = pk2(h[j][4], h[j][5]); a.w = pk2(h[j][6], h[j][7]);
                      b.x = pk2(h[j][8], h[j][9]); b.y = pk2(h[j][10], h[j][11]); b.z = pk2(h[j][12], h[j][13]); b.w = pk2(h[j][14], h[j][15]); o16[128 * j] = a; o16[128 * j + 1] = b; } }
              if constexpr (NQ7 > 0) { if constexpr (ROT7) hadamard64_row(h, F.lane); quant_row_store(h, F.lane, F.H2Q + (size_t)row * D, F.sA7 + row); }
              if (q + 1 < 8) { stc = stn;
#pragma unroll
                  for (int i = 0; i < 8; ++i) wcur[i] = wnx[i]; } } }
        __syncthreads();
    }
    xcd_barrier(bar);

    if constexpr (NQ7 > 0) { pg8::Gemm g{(const bf16_t*)F.H2Q, (const bf16_t*)F.W1Q, D / 2, D / 2, D / 2}; pg8::StaticOrder S; S.init(M, 256 * NQ7, F.G, F.bx);
      if constexpr (R8_HID) { pg8::EpiActR8 E{(unsigned char*)F.HID, FF, F.sA7, F.sB1, (float*)(ws + WS_CS8)};
          pg8::gemm_phase<pg8::EpiActR8, pg8::StaticOrder>(F.lds, g, S, E); }
      else { pg8::EpiActI8 E{F.HID, FF, F.sA7, F.sB1, I8_P8 ? F.hmax : nullptr};
          pg8::gemm_phase<pg8::EpiActI8, pg8::StaticOrder>(F.lds, g, S, E); } }
    if constexpr (NQ7 < 64) { pg8::Gemm g{F.HB, F.W1T + (size_t)256 * NQ7 * D, D, D, D}; pg8::StaticOrder S; S.init(M, FF - 256 * NQ7, F.G, F.bx);
      pg8::EpiBf16<1> E{F.HID + 256 * NQ7, FF, I8_P8 ? F.hmax : nullptr};
      pg8::gemm_phase<pg8::EpiBf16<1>, pg8::StaticOrder>(F.lds, g, S, E); }
    xcd_barrier(bar);

    if constexpr (I8_P8) {
        relaunder(F);
        if constexpr (R8_HID) { for (int r = gw; r < M; r += NGW) { float sc; requant_r8_row((const unsigned char*)F.HID + (size_t)r * FF, (const float*)(ws + WS_CS8) + (size_t)r * (FF / 64), F.lane, F.HIDQ + (size_t)r * FF, sc); if (F.lane == 0) F.sA8[r] = sc; } }
        else
        for (int r = gw; r < M; r += NGW) { float sc; int qs; const float rmax = __builtin_bit_cast(float, __builtin_amdgcn_readfirstlane(F.hmax[r])); quant_wide_row<true>(F.HID + (size_t)r * FF, F.lane, F.HIDQ + (size_t)r * FF, sc, qs, rmax); if (F.lane == 0) F.sA8[r] = sc; }
        xcd_barrier(bar);
    }

    if constexpr (I8_P8) { pg8::Gemm g{(const bf16_t*)F.HIDQ, (const bf16_t*)F.W2Q, FF / 2, FF / 2, FF / 2}; pg8::StaticOrder S; S.init(M, D, F.G, F.bx);
      pg8::EpiResidQ8 E{F.X1B, F.HB, F.modfull + 5 * D, F.stats2, F.sA8, F.sB2, F.cs2};
      pg8::gemm_phase<pg8::EpiResidQ8, pg8::StaticOrder>(F.lds, g, S, E); }
    else { pg8::Gemm g{F.HID, F.W2T, FF, FF, FF}; pg8::StaticOrder S; S.init(M, D, F.G, F.bx);
      pg8::EpiResid<true> E{F.X1B, F.HB, F.modfull + 5 * D, F.stats2};
      pg8::gemm_phase<pg8::EpiResid<true>, pg8::StaticOrder>(F.lds, g, S, E); }
    xcd_barrier(bar);

    relaunder(F);
    for (int row0 = gw * 4; row0 < M; row0 += 4 * NGW) {
        u32x4 w[4][8]; float st[4];
#pragma unroll
        for (int q = 0; q < 4; ++q) { const int row = row0 + q;
            if (row < M) { st[q] = F.stats2[(size_t)row * 64 + F.lane]; ld_row_bf16(F.HB + (size_t)row * D, F.lane, w[q]); } }
#pragma unroll
        for (int q = 0; q < 4; ++q) { const int row = row0 + q;
            if (row < M) { const float rs = 1.0f / sqrtf(wave_sum(st[q]) * (1.0f / D) + EPS);
#pragma unroll
                for (int j = 0; j < 8; ++j) { const int col = 8 * (64 * j + F.lane); float v[8]; { const u32x4 ww = w[q][j]; v[0] = pg8::hlo(ww.x); v[1] = pg8::hhi(ww.x); v[2] = pg8::hlo(ww.y); v[3] = pg8::hhi(ww.y); v[4] = pg8::hlo(ww.z); v[5] = pg8::hhi(ww.z); v[6] = pg8::hlo(ww.w); v[7] = pg8::hhi(ww.w); }
                    const f32x4 g0 = *(const GAS f32x4*)(F.gfin + col), g1 = *(const GAS f32x4*)(F.gfin + col + 4);
                    GAS f32x4* op = (GAS f32x4*)(F.out + (size_t)row * D + col);
                    op[0] = (f32x4){v[0] * rs * g0[0], v[1] * rs * g0[1], v[2] * rs * g0[2], v[3] * rs * g0[3]};
                    op[1] = (f32x4){v[4] * rs * g1[0], v[5] * rs * g1[1], v[6] * rs * g1[2], v[7] * rs * g1[3]}; } } }
    }
}

extern "C" void kernel_launch(void* const* d_in, const int* in_sizes, int n_in, void* d_out, int out_size, void* d_ws, size_t ws_size, hipStream_t stream) {
    static int grid = 0;
    if (grid == 0) {
        if (n_in != 17 || in_sizes[0] != M * D || out_size != M * D || ws_size < WS_END) { fprintf(stderr, "kernel_launch: unexpected shapes (n_in %d, in0 %d, out %d, ws %zu); nothing launched\n", n_in, n_in > 0 ? in_sizes[0] : -1, out_size, ws_size); grid = -1; return; }
        int dev = 0, cus = 0, per_cu = 0;
        if (hipGetDevice(&dev) != hipSuccess || hipDeviceGetAttribute(&cus, hipDeviceAttributeMultiprocessorCount, dev) != hipSuccess) { fprintf(stderr, "kernel_launch: device query failed\n"); grid = -1; return; }
        if (hipFuncSetAttribute((const void*)fwd_kernel, hipFuncAttributeMaxDynamicSharedMemorySize, LDS_BYTES) != hipSuccess) { fprintf(stderr, "kernel_launch: hipFuncSetAttribute failed\n"); grid = -1; return; }
        if (hipOccupancyMaxActiveBlocksPerMultiprocessor(&per_cu, (const void*)fwd_kernel, NWAVES * 64, LDS_BYTES) != hipSuccess || per_cu < 1)
            fprintf(stderr, "kernel_launch: note: occupancy query reports %d workgroups per CU\n", per_cu);
        (void)hipGetLastError();
        grid = cus;
    }
    if (grid < 0) return;
    if (hipMemsetAsync((char*)d_ws + WS_CTL, 0, CTL_ZERO_BYTES, stream) != hipSuccess) { fprintf(stderr, "kernel_launch: hipMemsetAsync failed\n"); return; }
    Args a{};
    for (int i = 0; i < 17; ++i) a.in[i] = (const float*)d_in[i];
    a.out = (float*)d_out; a.ws = (unsigned char*)d_ws;
    hipLaunchKernelGGL(fwd_kernel, dim3(grid), dim3(NWAVES * 64), LDS_BYTES, stream, a);
    const hipError_t le = hipPeekAtLastError();
    if (le != hipSuccess) fprintf(stderr, "kernel_launch: launch failed: %s\n", hipGetErrorName(le));
}
```
